# Optimizing an MI355X kernel written in HIP

```python
import math
import jax, jax.numpy as jnp
from jax import lax
import numpy as np

D_MODEL = 1024
BATCH = 2
SEQ = 8192
DEPTH = 1

PLE_DIM = 256
N_HEADS = 4
NOPE_DIM = 128
ROPE_DIM = 64
V_DIM = 128
QK_DIM = NOPE_DIM + ROPE_DIM
Q_LORA = 256
KV_LORA = 128
ATTN_WIDTH = N_HEADS * V_DIM
CONV_WIDTH = D_MODEL - ATTN_WIDTH
CONV_K = 3
ROPE_THETA = 10000.0
RMS_EPS = 1e-6
Q_BLOCK = 128
NEG_INF = -1e30
IN_WIDTHS = (Q_LORA, KV_LORA, ROPE_DIM, ATTN_WIDTH,
             CONV_WIDTH, CONV_WIDTH, CONV_WIDTH, CONV_WIDTH)
IN_TOTAL = Q_LORA + KV_LORA + ROPE_DIM + ATTN_WIDTH + 4 * CONV_WIDTH

kernel_name = "hymba_mla_shortconv_ple_block"


def rms_norm(x, g):
    xf = x.astype(jnp.float32)
    y = xf * lax.rsqrt(jnp.mean(xf * xf, axis=-1, keepdims=True) + RMS_EPS)
    return (y * g.astype(jnp.float32)).astype(x.dtype)


def rope_cos_sin(positions):
    inv_freq = 1.0 / (ROPE_THETA ** (jnp.arange(0, ROPE_DIM, 2, dtype=jnp.float32) / ROPE_DIM))
    ang = positions.astype(jnp.float32)[..., None] * inv_freq
    return jnp.cos(ang)[:, :, None, :], jnp.sin(ang)[:, :, None, :]


def apply_rope(t, cos, sin):
    tf = t.astype(jnp.float32)
    t1, t2 = tf[..., : ROPE_DIM // 2], tf[..., ROPE_DIM // 2:]
    out = jnp.concatenate([t1 * cos - t2 * sin, t2 * cos + t1 * sin], axis=-1)
    return out.astype(t.dtype)


def causal_block_attention(q, k, v):
    B, S, H, D = q.shape
    nb = S // Q_BLOCK
    scale = 1.0 / math.sqrt(D)
    q_blocks = q.reshape(B, nb, Q_BLOCK, H, D).transpose(1, 0, 2, 3, 4)
    k_pos = jnp.arange(S)

    def one_block(args):
        qb, bi = args
        s = jnp.einsum('bqhd,bkhd->bhqk', qb, k, preferred_element_type=jnp.float32) * scale
        q_pos = bi * Q_BLOCK + jnp.arange(Q_BLOCK)
        mask = k_pos[None, :] <= q_pos[:, None]
        s = jnp.where(mask[None, None], s, NEG_INF)
        pr = jax.nn.softmax(s, axis=-1).astype(v.dtype)
        return jnp.einsum('bhqk,bkhd->bqhd', pr, v)

    out = lax.map(one_block, (q_blocks, jnp.arange(nb)))
    return out.transpose(1, 0, 2, 3, 4).reshape(B, S, H, v.shape[-1])


def causal_depthwise_conv(u, w):
    C = u.shape[-1]
    return lax.conv_general_dilated(
        u, w[:, None, :].astype(u.dtype), window_strides=(1,),
        padding=[(CONV_K - 1, 0)], dimension_numbers=('NWC', 'WIO', 'NWC'),
        feature_group_count=C)


def hybrid_layer(x, p_i, cos, sin, g_in, w_in, g_cq, w_uq, g_ckv, w_ukv, g_q, g_k,
                 conv_w, g_oa, g_oc, w_o, w_pl, w_plg, g_pl):
    B, S, _ = x.shape
    h = rms_norm(x, g_in)
    proj = h @ w_in
    splits, acc = [], 0
    for wdt in IN_WIDTHS[:-1]:
        acc += wdt
        splits.append(acc)
    c_q, c_kv, k_pe, z_a, cb, cc, cx, z_c = jnp.split(proj, splits, axis=-1)

    q = (rms_norm(c_q, g_cq) @ w_uq).reshape(B, S, N_HEADS, QK_DIM)
    kv = (rms_norm(c_kv, g_ckv) @ w_ukv).reshape(B, S, N_HEADS, NOPE_DIM + V_DIM)
    k_nope, v = kv[..., :NOPE_DIM], kv[..., NOPE_DIM:]
    k = jnp.concatenate(
        [k_nope, jnp.broadcast_to(k_pe[:, :, None, :], (B, S, N_HEADS, ROPE_DIM))], axis=-1)
    q = rms_norm(q, g_q)
    k = rms_norm(k, g_k)
    q = jnp.concatenate([q[..., :NOPE_DIM], apply_rope(q[..., NOPE_DIM:], cos, sin)], axis=-1)
    k = jnp.concatenate([k[..., :NOPE_DIM], apply_rope(k[..., NOPE_DIM:], cos, sin)], axis=-1)
    o_attn = causal_block_attention(q, k, v).reshape(B, S, ATTN_WIDTH)
    y_attn = rms_norm(o_attn * jax.nn.silu(z_a), g_oa)

    u = causal_depthwise_conv(cc * cx, conv_w)
    y_conv = rms_norm(cb * u * jax.nn.silu(z_c), g_oc)

    x = x + jnp.concatenate([y_attn, y_conv], axis=-1) @ w_o

    gate = jax.nn.sigmoid(rms_norm(x, g_pl) @ w_plg)
    return x + gate * (p_i @ w_pl)


def setup_inputs(seed: int = 0) -> dict:
    key = jax.random.key(seed)
    ks = jax.random.split(key, 20)
    f32 = jnp.float32

    def nrm(k, shape, fan_in):
        return jax.random.normal(k, shape, f32) * (fan_in ** -0.5)

    def gain(k, n):
        return 1.0 + 0.02 * jax.random.normal(k, (DEPTH, n), f32)

    x = jax.random.normal(ks[0], (BATCH, SEQ, D_MODEL), f32)
    p = jax.random.normal(ks[1], (DEPTH, BATCH, SEQ, PLE_DIM), f32)
    positions = jnp.broadcast_to(jnp.arange(SEQ, dtype=jnp.int32)[None, :], (BATCH, SEQ))
    return {
        "x": x,
        "p": p,
        "positions": positions,
        "g_in": gain(ks[2], D_MODEL),
        "w_in": nrm(ks[3], (DEPTH, D_MODEL, IN_TOTAL), D_MODEL),
        "g_cq": gain(ks[4], Q_LORA),
        "w_uq": nrm(ks[5], (DEPTH, Q_LORA, N_HEADS * QK_DIM), Q_LORA),
        "g_ckv": gain(ks[6], KV_LORA),
        "w_ukv": nrm(ks[7], (DEPTH, KV_LORA, N_HEADS * (NOPE_DIM + V_DIM)), KV_LORA),
        "g_q": gain(ks[8], QK_DIM),
        "g_k": gain(ks[9], QK_DIM),
        "conv_w": nrm(ks[10], (DEPTH, CONV_K, CONV_WIDTH), CONV_K),
        "g_oa": gain(ks[11], ATTN_WIDTH),
        "g_oc": gain(ks[12], CONV_WIDTH),
        "w_o": nrm(ks[13], (DEPTH, D_MODEL, D_MODEL), D_MODEL),
        "w_pl": nrm(ks[14], (DEPTH, PLE_DIM, D_MODEL), PLE_DIM),
        "w_plg": nrm(ks[15], (DEPTH, D_MODEL, D_MODEL), D_MODEL),
        "g_pl": gain(ks[16], D_MODEL),
    }


def reference(x, p, positions, g_in, w_in, g_cq, w_uq, g_ckv, w_ukv, g_q, g_k,
              conv_w, g_oa, g_oc, w_o, w_pl, w_plg, g_pl):
    cos, sin = rope_cos_sin(positions)
    h = x
    for i in range(DEPTH):
        h = hybrid_layer(h, p[i], cos, sin, g_in[i], w_in[i], g_cq[i], w_uq[i],
                         g_ckv[i], w_ukv[i], g_q[i], g_k[i], conv_w[i], g_oa[i],
                         g_oc[i], w_o[i], w_pl[i], w_plg[i], g_pl[i])
    return h.astype(x.dtype)
```

```cpp
#include <hip/hip_runtime.h>
#include <hip/hip_cooperative_groups.h>
#include <cstdio>
#include <cstdint>
namespace cg = cooperative_groups;

typedef __bf16 bf16x2v_t __attribute__((ext_vector_type(2)));
typedef float f32x2_t __attribute__((ext_vector_type(2)));
__device__ __forceinline__ unsigned pk2(float a, float b) { f32x2_t v = {a, b}; bf16x2v_t r = __builtin_convertvector(v, bf16x2v_t); return __builtin_bit_cast(unsigned, r); }
__device__ __forceinline__ float bflo(unsigned u) { return __uint_as_float(u << 16); }
__device__ __forceinline__ float bfhi(unsigned u) { return __uint_as_float(u & 0xffff0000u); }
__device__ __forceinline__ float bf1(unsigned short u) { return __uint_as_float(((unsigned)u) << 16); }

namespace pg8 {
#define PG8_LAS __attribute__((address_space(3)))
typedef unsigned short bf16_t;
typedef short bf16x8 __attribute__((ext_vector_type(8)));
typedef float f32x4 __attribute__((ext_vector_type(4)));
typedef unsigned u32x4 __attribute__((ext_vector_type(4)));
constexpr int BM = 256, BK = 64, HALF = 128, HTB = HALF * BK * 2  , STAGE_BYTES = 8 * HTB, NXCD = 8, WGM = 8;

__host__ __device__ __forceinline__ int lds_byte(int r, int c) { const int st = (r >> 4) * 2 + (c >> 5), rr = r & 15, cc = c & 31, ob = rr * 64 + cc * 2; return st * 1024 + (ob ^ (((ob >> 9) & 1) << 5)); }
__host__ __device__ __forceinline__ void stage_rc(int b, int& R, int& C) { const int st = b / 1024, sb = b % 1024, swz = sb ^ (((sb >> 9) & 1) << 5); R = (st >> 1) * 16 + swz / 64; C = (st & 1) * 32 + (swz % 64) / 2; }
__host__ __device__ __forceinline__ int perm32(int rho) { const int n = rho >> 4, i = rho & 15; return 8 * (i >> 2) + 4 * n + (i & 3); }

struct Unit { int pm, pn; };
struct Gemm { const bf16_t* A; const bf16_t* Bt; int M, N, K, lda; };

struct StaticOrder {
    int nM, nN, nwg, G, c;
    __host__ __device__ void init(int M, int N, int G_, int c_) { nM = M / BM; nN = N / BM; nwg = nM * nN; G = G_; c = c_; }
    __host__ __device__ bool next(int i, Unit& u) const {
        const long L = (long)i * G + c; if (L >= nwg) return false;
        int wgid = (int)L; { const int q = nwg / NXCD, r = nwg % NXCD, xcd = wgid % NXCD, off = wgid / NXCD; wgid = (xcd < r ? xcd * (q + 1) : r * (q + 1) + (xcd - r) * q) + off; }
        const int nig = WGM * nN, gid = wgid / nig, fm = gid * WGM, gsz = (nM - fm) < WGM ? (nM - fm) : WGM;
        u.pm = fm + ((wgid % nig) % gsz); u.pn = (wgid % nig) / gsz; return true;
    }
    __device__ __forceinline__ void a_ready(const Unit&) const {}
    __device__ __forceinline__ void done(const Unit&) const {}
};


template <int ACT  > struct EpiBf16 {
    static constexpr bool PERM = true, AFTER_DRAIN = false;
    bf16_t* O; int ldc;
    __device__ __forceinline__ void operator()(const f32x4 (&acc)[2][2][4][2], const Unit& u, int wr, int wc, int fr, int fq) const {
        const int row0 = u.pm * BM + wr * 64 + fr; const int col0 = u.pn * BM + wc * 32 + 8 * fq;
#pragma unroll
        for (int ai = 0; ai < 2; ++ai)
#pragma unroll
            for (int m = 0; m < 4; ++m) { bf16_t* rowp = O + (size_t)(row0 + ai * HALF + m * 16) * ldc + col0;
#pragma unroll
                for (int bj = 0; bj < 2; ++bj) { f32x4 v0 = acc[ai][bj][m][0], v1 = acc[ai][bj][m][1];
                    if (ACT == 1) {
#pragma unroll
                        for (int e = 0; e < 4; ++e) { v0[e] = 1.f / (1.f + __expf(-v0[e])); v1[e] = 1.f / (1.f + __expf(-v1[e])); }
                    }
                    if (ACT == 2) {
                        const bool act = (u.pn >= 2);
#pragma unroll
                        for (int e = 0; e < 4; ++e) { const float s0 = v0[e] * __builtin_amdgcn_rcpf(1.f + __builtin_amdgcn_exp2f(-1.4426950408889634f * v0[e])), s1 = v1[e] * __builtin_amdgcn_rcpf(1.f + __builtin_amdgcn_exp2f(-1.4426950408889634f * v1[e]));
                            v0[e] = act ? s0 : v0[e]; v1[e] = act ? s1 : v1[e]; }
                    }
                    u32x4 w; w.x = pk2(v0[0], v0[1]); w.y = pk2(v0[2], v0[3]); w.z = pk2(v1[0], v1[1]); w.w = pk2(v1[2], v1[3]);
                    *(u32x4*)(rowp + bj * HALF) = w; } }
    }
};
struct EpiProjB {
    static constexpr bool PERM = false, AFTER_DRAIN = false;
    bf16_t* O; int ldc;
    __device__ __forceinline__ void operator()(const f32x4 (&acc)[2][2][4][2], const Unit& u, int wr, int wc, int fr, int fq) const {
        typedef unsigned u32x2 __attribute__((ext_vector_type(2)));
        const int row0 = u.pm * BM + wr * 64 + fr;
        const int ch0 = u.pn * 64 + 16 * wc + 4 * fq;
#pragma unroll
        for (int ai = 0; ai < 2; ++ai)
#pragma unroll
            for (int m = 0; m < 4; ++m) { bf16_t* rowp = O + (size_t)(row0 + ai * HALF + m * 16) * ldc + ch0;
                const f32x4 cb = acc[ai][0][m][0], zc = acc[ai][0][m][1], cc = acc[ai][1][m][0], cx = acc[ai][1][m][1]; f32x4 g, pr;
#pragma unroll
                for (int e = 0; e < 4; ++e) { g[e] = cb[e] * zc[e] * __builtin_amdgcn_rcpf(1.f + __builtin_amdgcn_exp2f(-1.4426950408889634f * zc[e])); pr[e] = cc[e] * cx[e]; }
                u32x2 w; w.x = pk2(g[0], g[1]); w.y = pk2(g[2], g[3]); *(u32x2*)(rowp + 1024) = w;
                w.x = pk2(pr[0], pr[1]); w.y = pk2(pr[2], pr[3]); *(u32x2*)(rowp + 1536) = w; }
    }
};
struct EpiX1 {
    static constexpr bool PERM = true, AFTER_DRAIN = false;
    const float* base; float* out; bf16_t* xb; float* rowsq; int ldc;
    __device__ __forceinline__ void operator()(const f32x4 (&acc)[2][2][4][2], const Unit& u, int wr, int wc, int fr, int fq) const {
        const int row0 = u.pm * BM + wr * 64 + fr; const int col0 = u.pn * BM + wc * 32 + 8 * fq;
#pragma unroll
        for (int ai = 0; ai < 2; ++ai)
#pragma unroll
            for (int m = 0; m < 4; ++m) { const int row = row0 + ai * HALF + m * 16; const size_t off = (size_t)row * ldc + col0; float s = 0.f;
#pragma unroll
                for (int bj = 0; bj < 2; ++bj) { const size_t o2 = off + bj * HALF;
                    const f32x4 v0 = *(const f32x4*)(base + o2) + acc[ai][bj][m][0], v1 = *(const f32x4*)(base + o2 + 4) + acc[ai][bj][m][1];
                    u32x4 w; w.x = pk2(v0[0], v0[1]); w.y = pk2(v0[2], v0[3]); w.z = pk2(v1[0], v1[1]); w.w = pk2(v1[2], v1[3]); *(u32x4*)(xb + o2) = w;
                    s += ((v0[0] * v0[0] + v0[1] * v0[1]) + (v0[2] * v0[2] + v0[3] * v0[3])) + ((v1[0] * v1[0] + v1[1] * v1[1]) + (v1[2] * v1[2] + v1[3] * v1[3])); }
                s += __shfl_xor(s, 16); s += __shfl_xor(s, 32);
                if (fq == 0) atomicAdd(rowsq + row, s);
                if (m & 1) asm volatile("" ::: "memory"); }
    }
};
struct EpiPl {
    static constexpr bool PERM = true, AFTER_DRAIN = false;
    bf16_t* pl; int ldc;
    __device__ __forceinline__ void operator()(const f32x4 (&acc)[2][2][4][2], const Unit& u, int wr, int wc, int fr, int fq) const {
        const int row0 = u.pm * BM + wr * 64 + fr; const int col0 = u.pn * BM + wc * 32 + 8 * fq;
#pragma unroll
        for (int ai = 0; ai < 2; ++ai)
#pragma unroll
            for (int m = 0; m < 4; ++m) { const size_t off = (size_t)(row0 + ai * HALF + m * 16) * ldc + col0;
#pragma unroll
                for (int bj = 0; bj < 2; ++bj) { const f32x4 v0 = acc[ai][bj][m][0], v1 = acc[ai][bj][m][1];
                    u32x4 w; w.x = pk2(v0[0], v0[1]); w.y = pk2(v0[2], v0[3]); w.z = pk2(v1[0], v1[1]); w.w = pk2(v1[2], v1[3]); *(u32x4*)(pl + off + bj * HALF) = w; } }
    }
};
struct EpiGateOut {
    static constexpr bool PERM = true, AFTER_DRAIN = false;
    const bf16_t* pl; const bf16_t* xb; float* out; const float* rowsq; int ldc; float eps;
    __device__ __forceinline__ void operator()(const f32x4 (&acc)[2][2][4][2], const Unit& u, int wr, int wc, int fr, int fq) const {
        const int row0 = u.pm * BM + wr * 64 + fr; const int col0 = u.pn * BM + wc * 32 + 8 * fq;
#pragma unroll
        for (int ai = 0; ai < 2; ++ai)
#pragma unroll
            for (int m = 0; m < 4; ++m) { const int row = row0 + ai * HALF + m * 16; const size_t off = (size_t)row * ldc + col0;
                const float nrl = -1.4426950408889634f * __builtin_amdgcn_rsqf(__hip_atomic_load(rowsq + row, __ATOMIC_RELAXED, __HIP_MEMORY_SCOPE_AGENT) * (1.f / (float)ldc) + eps);
#pragma unroll
                for (int bj = 0; bj < 2; ++bj) { const size_t o2 = off + bj * HALF; const u32x4 xw = *(const u32x4*)(xb + o2), g = *(const u32x4*)(pl + o2);
                    f32x4 b0, b1, p0, p1;
                    b0[0] = __uint_as_float(xw.x << 16); b0[1] = __uint_as_float(xw.x & 0xffff0000u); b0[2] = __uint_as_float(xw.y << 16); b0[3] = __uint_as_float(xw.y & 0xffff0000u);
                    b1[0] = __uint_as_float(xw.z << 16); b1[1] = __uint_as_float(xw.z & 0xffff0000u); b1[2] = __uint_as_float(xw.w << 16); b1[3] = __uint_as_float(xw.w & 0xffff0000u);
                    p0[0] = __uint_as_float(g.x << 16); p0[1] = __uint_as_float(g.x & 0xffff0000u); p0[2] = __uint_as_float(g.y << 16); p0[3] = __uint_as_float(g.y & 0xffff0000u);
                    p1[0] = __uint_as_float(g.z << 16); p1[1] = __uint_as_float(g.z & 0xffff0000u); p1[2] = __uint_as_float(g.w << 16); p1[3] = __uint_as_float(g.w & 0xffff0000u);
                    f32x4 s0, s1;
#pragma unroll
                    for (int e = 0; e < 4; ++e) { s0[e] = __builtin_amdgcn_rcpf(1.f + __builtin_amdgcn_exp2f(nrl * acc[ai][bj][m][0][e])); s1[e] = __builtin_amdgcn_rcpf(1.f + __builtin_amdgcn_exp2f(nrl * acc[ai][bj][m][1][e])); }
                    *(f32x4*)(out + o2) = b0 + s0 * p0; *(f32x4*)(out + o2 + 4) = b1 + s1 * p1; }
                if (m & 1) asm volatile("" ::: "memory"); }
    }
};

template <class Epi, class Sched, bool ALIGN_EPI = false, bool SP2 = false>
__device__ __forceinline__ void gemm_phase(PG8_LAS unsigned char* lds, const Gemm g, const Sched& S, const Epi& E) {
    int tid_ = threadIdx.x; asm volatile("" : "+v"(tid_));
    const int tid = tid_, wid = __builtin_amdgcn_readfirstlane(tid >> 6), lane = tid & 63, wr = wid >> 2, wc = wid & 3, fr = lane & 15, fq = lane >> 4;
    const int K = g.K, nt = K / BK;
    unsigned voffA[2], voffB[2];
#pragma unroll
    for (int i = 0; i < 2; ++i) { int R, C; stage_rc(tid * 16 + i * 8192, R, C); const int Rb = Epi::PERM ? ((R & ~31) + perm32(R & 31)) : R;
        voffA[i] = (unsigned)(R * g.lda + C) * 2u; voffB[i] = (unsigned)(Rb * K + C) * 2u; }
    const size_t kstep = (size_t)(BK * 2);
    const size_t hstepB = (size_t)HALF * K * 2, hstepA = (size_t)HALF * g.lda * 2;
    const size_t tstepB = 2 * hstepB, tstepA = 2 * hstepA;
    const unsigned ldsw = (unsigned)wid * 1024u;
    const int aoff = lds_byte(wr * 64 + fr, fq * 8), boff = lds_byte(wc * 32 + fr, fq * 8);
#define PG8_SA(b, h) (((b) * 2 + (h)) * HTB)
#define PG8_SB(b, h) ((4 + (b) * 2 + (h)) * HTB)
#define PG8_STAGE(bufoff, gbase, voff) do { _Pragma("unroll") for (int _i = 0; _i < 2; ++_i) \
        __builtin_amdgcn_global_load_lds((const unsigned*)((const char*)(gbase) + (voff)[_i]), (PG8_LAS unsigned*)(lds + (bufoff) + ldsw + _i * 8192), 16, 0, 0); } while (0)
#define PG8_LDA(dst, b, h) do { _Pragma("unroll") for (int m = 0; m < 4; ++m) _Pragma("unroll") for (int k = 0; k < 2; ++k) dst[m][k] = *(const PG8_LAS bf16x8*)(lds + PG8_SA(b, h) + aoff + m * 2048 + k * 1024); } while (0)
#define PG8_LDB(dst, b, h) do { _Pragma("unroll") for (int n = 0; n < 2; ++n) _Pragma("unroll") for (int k = 0; k < 2; ++k) dst[n][k] = *(const PG8_LAS bf16x8*)(lds + PG8_SB(b, h) + boff + n * 2048 + k * 1024); } while (0)
#define PG8_MMA(ai, bj, At, Bt) do { __builtin_amdgcn_s_setprio(1); _Pragma("unroll") for (int m = 0; m < 4; ++m) _Pragma("unroll") for (int n = 0; n < 2; ++n) _Pragma("unroll") for (int k = 0; k < 2; ++k) \
        acc[ai][bj][m][n] = __builtin_amdgcn_mfma_f32_16x16x32_bf16(Bt[n][k], At[m][k], acc[ai][bj][m][n], 0, 0, 0); __builtin_amdgcn_s_setprio(0); } while (0)
#define PG8_WAIT_V(n) asm volatile("s_waitcnt vmcnt(" #n ")" ::: "memory")
#define PG8_WAIT_L(n) asm volatile("s_waitcnt lgkmcnt(" #n ")" ::: "memory")
#define PG8_BAR __builtin_amdgcn_s_barrier()
#define PG8_SCHED __builtin_amdgcn_sched_barrier(0)
    Unit cur, nxt; int ui = 0;
    if (!S.next(0, cur)) return;
    f32x4 acc[2][2][4][2];
#pragma unroll
    for (int a = 0; a < 2; ++a)
#pragma unroll
        for (int b = 0; b < 2; ++b)
#pragma unroll
            for (int m = 0; m < 4; ++m)
#pragma unroll
                for (int n = 0; n < 2; ++n) acc[a][b][m][n] = (f32x4){0.f, 0.f, 0.f, 0.f};
    bf16x8 At[4][2], B0[2][2], B1[2][2];
    const char* cA = (const char*)g.A + (size_t)cur.pm * tstepA; const char* cB = (const char*)g.Bt + (size_t)cur.pn * tstepB;
    S.a_ready(cur);
    if constexpr (SP2) {
        PG8_STAGE(PG8_SB(0, 0), cB, voffB); PG8_STAGE(PG8_SB(0, 1), cB + hstepB, voffB); PG8_STAGE(PG8_SA(0, 0), cA, voffA); PG8_STAGE(PG8_SA(0, 1), cA + hstepA, voffA);
        if (wr == 1) PG8_BAR;
        PG8_WAIT_V(2); PG8_BAR;
        PG8_STAGE(PG8_SB(1, 0), cB + kstep, voffB); PG8_STAGE(PG8_SA(1, 0), cA + kstep, voffA); PG8_STAGE(PG8_SB(1, 1), cB + hstepB + kstep, voffB);
        PG8_WAIT_V(6); PG8_BAR;
    } else {
        PG8_STAGE(PG8_SB(0, 0), cB, voffB); PG8_STAGE(PG8_SA(0, 0), cA, voffA); PG8_STAGE(PG8_SB(0, 1), cB + hstepB, voffB); PG8_STAGE(PG8_SA(0, 1), cA + hstepA, voffA);
        if (wr == 1) PG8_BAR;
        PG8_WAIT_V(4); PG8_BAR;
        PG8_STAGE(PG8_SB(1, 0), cB + kstep, voffB); PG8_STAGE(PG8_SA(1, 0), cA + kstep, voffA); PG8_STAGE(PG8_SB(1, 1), cB + hstepB + kstep, voffB);
        PG8_WAIT_V(6); PG8_BAR;
    }
    for (;;) {
        const bool has_next = S.next(ui + 1, nxt);
        const char* nA = has_next ? (const char*)g.A + (size_t)nxt.pm * tstepA : cA; const char* nB = has_next ? (const char*)g.Bt + (size_t)nxt.pn * tstepB : cB;
        for (int t = 0; t < nt; t += 2) {
            const bool last = (t == nt - 2);
            const char* a1 = cA + (size_t)(t + 1) * kstep;
            const char* a2 = last ? nA : cA + (size_t)(t + 2) * kstep; const char* b2 = last ? nB : cB + (size_t)(t + 2) * kstep;
            const char* a3 = a2 + kstep; const char* b3 = b2 + kstep;
            if (last && has_next) S.a_ready(nxt);
            if constexpr (SP2) {
            PG8_LDB(B0, 0, 0); PG8_LDB(B1, 0, 1); PG8_SCHED; PG8_LDA(At, 0, 0); PG8_STAGE(PG8_SA(1, 1), a1 + hstepA, voffA);
            PG8_WAIT_V(8); PG8_WAIT_L(0); PG8_BAR; PG8_MMA(0, 0, At, B0); PG8_MMA(0, 1, At, B1); PG8_BAR; PG8_SCHED;
            PG8_LDA(At, 0, 1); PG8_STAGE(PG8_SB(0, 0), b2, voffB); PG8_STAGE(PG8_SB(0, 1), b2 + hstepB, voffB); PG8_STAGE(PG8_SA(0, 0), a2, voffA);
            PG8_WAIT_V(8); PG8_WAIT_L(0); PG8_BAR; PG8_MMA(1, 0, At, B0); PG8_MMA(1, 1, At, B1); PG8_BAR; PG8_SCHED;
            PG8_LDB(B0, 1, 0); PG8_LDB(B1, 1, 1); PG8_SCHED; PG8_LDA(At, 1, 0); PG8_STAGE(PG8_SA(0, 1), a2 + hstepA, voffA);
            PG8_WAIT_V(8); PG8_WAIT_L(0); PG8_BAR; PG8_MMA(0, 0, At, B0); PG8_MMA(0, 1, At, B1); PG8_BAR; PG8_SCHED;
            PG8_LDA(At, 1, 1); PG8_STAGE(PG8_SB(1, 0), b3, voffB); PG8_STAGE(PG8_SB(1, 1), b3 + hstepB, voffB); PG8_STAGE(PG8_SA(1, 0), a3, voffA);
            PG8_WAIT_V(8); PG8_WAIT_L(0); PG8_BAR; PG8_MMA(1, 0, At, B0); PG8_MMA(1, 1, At, B1); PG8_BAR; PG8_SCHED;
            } else {
            PG8_LDB(B0, 0, 0); PG8_SCHED; PG8_LDA(At, 0, 0); PG8_STAGE(PG8_SA(1, 1), a1 + hstepA, voffA);
            PG8_WAIT_L(8); PG8_BAR; PG8_WAIT_L(0); PG8_MMA(0, 0, At, B0); PG8_BAR; PG8_SCHED;
            PG8_LDB(B1, 0, 1); PG8_STAGE(PG8_SB(0, 0), b2, voffB);
            PG8_BAR; PG8_WAIT_L(0); PG8_MMA(0, 1, At, B1); PG8_BAR;
            PG8_LDA(At, 0, 1); PG8_STAGE(PG8_SA(0, 0), a2, voffA);
            PG8_BAR; PG8_WAIT_L(0); PG8_MMA(1, 0, At, B0); PG8_BAR; PG8_SCHED;
            PG8_STAGE(PG8_SB(0, 1), b2 + hstepB, voffB);
            PG8_WAIT_V(6); PG8_BAR; PG8_MMA(1, 1, At, B1); PG8_BAR;
            PG8_LDB(B0, 1, 0); PG8_SCHED; PG8_LDA(At, 1, 0); PG8_STAGE(PG8_SA(0, 1), a2 + hstepA, voffA);
            PG8_WAIT_L(8); PG8_BAR; PG8_WAIT_L(0); PG8_MMA(0, 0, At, B0); PG8_BAR; PG8_SCHED;
            PG8_LDB(B1, 1, 1); PG8_STAGE(PG8_SB(1, 0), b3, voffB);
            PG8_BAR; PG8_WAIT_L(0); PG8_MMA(0, 1, At, B1); PG8_BAR;
            PG8_LDA(At, 1, 1); PG8_STAGE(PG8_SA(1, 0), a3, voffA);
            PG8_BAR; PG8_WAIT_L(0); PG8_MMA(1, 0, At, B0); PG8_BAR; PG8_SCHED;
            PG8_STAGE(PG8_SB(1, 1), b3 + hstepB, voffB);
            PG8_WAIT_V(6); PG8_BAR; PG8_MMA(1, 1, At, B1); PG8_BAR;
            }
        }
        if constexpr (ALIGN_EPI) { if (wr == 0) PG8_BAR; }
        if constexpr (!Epi::AFTER_DRAIN) { int fr_ = fr, fq_ = fq; asm volatile("" : "+v"(fr_), "+v"(fq_));
            E(acc, cur, wr, wc, fr_, fq_); S.done(cur); }
        if (!has_next) break;
#pragma unroll
        for (int a = 0; a < 2; ++a)
#pragma unroll
            for (int b = 0; b < 2; ++b)
#pragma unroll
                for (int m = 0; m < 4; ++m)
#pragma unroll
                    for (int n = 0; n < 2; ++n) acc[a][b][m][n] = (f32x4){0.f, 0.f, 0.f, 0.f};
        cur = nxt; cA = nA; cB = nB; ++ui;
        if constexpr (ALIGN_EPI) { if (wr == 1) PG8_BAR; }
    }
    PG8_WAIT_V(0);
    if constexpr (!ALIGN_EPI) { if (wr == 0) PG8_BAR; }
    PG8_BAR;
    if constexpr (Epi::AFTER_DRAIN) { E.fused(acc, cur, wr, wc, fr, fq, lds, wid, lane); S.done(cur); }
#undef PG8_SA
#undef PG8_SB
#undef PG8_STAGE
#undef PG8_LDA
#undef PG8_LDB
#undef PG8_MMA
#undef PG8_WAIT_V
#undef PG8_WAIT_L
#undef PG8_BAR
#undef PG8_SCHED
}
}

constexpr int BATCH = 2, SEQ = 8192, DM = 1024, T = BATCH * SEQ;
constexpr int PLE = 256, NH = 4, NOPE = 128, ROPE = 64, VD = 128, QKD = 192, QLORA = 256, KVLORA = 128, AW = 512, CW = 512;
constexpr int INTOT = 3008, INPAD = 3072;
constexpr int PP = 2048;
constexpr int C_CQ = 0, C_CKV = 256, C_KPE = 384, C_ZA = 512, C_G = 1024, C_PR = 1536;
constexpr int UPK = 384, UPN = 1792;
constexpr float EPS = 1e-6f;
constexpr int NWAVES = 8, NTHREADS = 512;

constexpr size_t MiB = 1u << 20;
constexpr size_t WS_WIN = 0;
constexpr size_t WS_WUP = 6 * MiB;
constexpr size_t WS_WO = 8 * MiB;
constexpr size_t WS_WPLG = 10 * MiB;
constexpr size_t WS_WPL = 12 * MiB;
constexpr size_t WS_XN = 16 * MiB;
constexpr size_t WS_PB = 48 * MiB;
constexpr size_t WS_PROJ = 56 * MiB;
constexpr size_t WS_QKVRAW = 152 * MiB;
constexpr size_t WS_K = 208 * MiB;
constexpr size_t WS_VT = 232 * MiB;
constexpr size_t WS_END = 248 * MiB;
constexpr size_t WS_ROWSQ = 14 * MiB;
constexpr size_t WS_X1B = WS_PROJ;
constexpr size_t WS_PL = WS_PROJ + 64 * MiB;

#define LAS __attribute__((address_space(3)))
typedef unsigned short bf16_t;
typedef short bf16x8 __attribute__((ext_vector_type(8)));
typedef float f32x4 __attribute__((ext_vector_type(4)));
typedef float f32x16 __attribute__((ext_vector_type(16)));
typedef unsigned u32x4 __attribute__((ext_vector_type(4)));
typedef unsigned u32x2 __attribute__((ext_vector_type(2)));

struct Args {
    const float* x; const float* p; const int* pos; const float* g_in; const float* w_in; const float* g_cq; const float* w_uq; const float* g_ckv; const float* w_ukv;
    const float* g_q; const float* g_k; const float* conv_w; const float* g_oa; const float* g_oc; const float* w_o; const float* w_pl; const float* w_plg; const float* g_pl;
    float* out; unsigned char* ws; int never; int pad;
};

__device__ __forceinline__ float wave_sum(float v) {
#pragma unroll
    for (int o = 1; o < 64; o <<= 1) v += __shfl_xor(v, o);
    return v;
}
__device__ __forceinline__ float max_xor32(float x) { const u32x2 r = __builtin_amdgcn_permlane32_swap(__float_as_uint(x), __float_as_uint(x), false, false); return fmaxf(__uint_as_float(r.x), __uint_as_float(r.y)); }
__device__ __forceinline__ float silu_f(float z) { return z / (1.f + __expf(-z)); }

__device__ __forceinline__ int win_row(int n) {
    if (n < 448) return n;
    if (n < 960) return n + 64;
    const int t = n - 960, q = t >> 9, ch = t & 511, qn = (q == 0) ? 0 : (q == 1) ? 2 : (q == 2) ? 3 : 1, cg = ch >> 6, ci = ch & 63;
    return 1024 + 256 * cg + 128 * (qn >> 1) + 32 * (ci >> 4) + 16 * (qn & 1) + (ci & 15);
}
template <bool WINMAP = false>
__device__ __forceinline__ void p0_transpose_item(const float* W, int N, bf16_t* WT, int ldt, int row_off, int col_off, LAS float* scr, int item, int lane, const float* gk = nullptr) {
    const int nblk = N / 32, kb = item / nblk, nb = item % nblk, k0 = 64 * kb, n0 = 32 * nb;
    { f32x4 v[8];
#pragma unroll
      for (int i = 0; i < 8; ++i) v[i] = *(const f32x4*)(W + (size_t)(k0 + 8 * i + (lane >> 3)) * N + n0 + 4 * (lane & 7));
#pragma unroll
      for (int i = 0; i < 8; ++i) { const int kk = 8 * i + (lane >> 3); const float gg = gk ? gk[k0 + kk] : 1.f; LAS float* d = scr + kk * 33 + 4 * (lane & 7);
          d[0] = v[i][0] * gg; d[1] = v[i][1] * gg; d[2] = v[i][2] * gg; d[3] = v[i][3] * gg; } }
    asm volatile("s_waitcnt lgkmcnt(0)" ::: "memory");
    const int c = lane & 7;
#pragma unroll
    for (int j = 0; j < 4; ++j) { const int n = (lane >> 3) + 8 * j; const LAS float* s = scr + (8 * c) * 33 + n;
        u32x4 o; o.x = pk2(s[0 * 33], s[1 * 33]); o.y = pk2(s[2 * 33], s[3 * 33]); o.z = pk2(s[4 * 33], s[5 * 33]); o.w = pk2(s[6 * 33], s[7 * 33]);
        *(u32x4*)(WT + (size_t)(WINMAP ? win_row(n0 + n) : row_off + n0 + n) * ldt + col_off + k0 + 8 * c) = o; }
    asm volatile("s_waitcnt lgkmcnt(0)" ::: "memory");
}

__device__ __forceinline__ void phase0(const Args& a, LAS unsigned char* lds, int gw_, int NGW, int wave, int lane_) {
    int lane = lane_; asm volatile("" : "+v"(lane));
    const int gw = blockIdx.x * NWAVES + wave;
    unsigned char* ws = a.ws;
    bf16_t* WinT = (bf16_t*)(ws + WS_WIN); bf16_t* WupT = (bf16_t*)(ws + WS_WUP); bf16_t* WoT = (bf16_t*)(ws + WS_WO); bf16_t* WplgT = (bf16_t*)(ws + WS_WPLG); bf16_t* WplT = (bf16_t*)(ws + WS_WPL);
    LAS float* scr = (LAS float*)(lds + wave * 16384);
    constexpr int I_IN = (DM / 64) * (INTOT / 32), I_UQ = (QLORA / 64) * (768 / 32), I_UKV = (KVLORA / 64) * (1024 / 32), I_O = (DM / 64) * (DM / 32), I_PLG = I_O, I_PL = (PLE / 64) * (DM / 32);
    constexpr int NITEMS = I_IN + I_UQ + I_UKV + I_PL;
    (void)I_O; (void)I_PLG; (void)WoT; (void)WplgT;
    for (int it = gw; it < NITEMS; it += NGW) {
        int r = it;
        if (r < I_IN) { p0_transpose_item<true>(a.w_in, INTOT, WinT, DM, 0, 0, scr, r, lane); continue; } r -= I_IN;
        if (r < I_UQ) { p0_transpose_item(a.w_uq, 768, WupT, UPK, 0, 0, scr, r, lane, a.g_cq); continue; } r -= I_UQ;
        if (r < I_UKV) { p0_transpose_item(a.w_ukv, 1024, WupT, UPK, 768, 256, scr, r, lane, a.g_ckv); continue; } r -= I_UKV;
        p0_transpose_item(a.w_pl, DM, WplT, PLE, 0, 0, scr, r, lane);
    }
    const int gt = gw * 64 + lane, NGT = NGW * 64;
    for (int c = gt; c < (INPAD - INTOT) * DM / 8; c += NGT) *(u32x4*)(WinT + (size_t)448 * DM + (size_t)c * 8) = (u32x4){0u, 0u, 0u, 0u};
    for (int c = gt; c < UPN * (UPK / 8); c += NGT) { const int row = c / (UPK / 8), col = (c % (UPK / 8)) * 8; const bool diag = (row < 768) ? (col < 256) : (col >= 256);
        if (!diag) *(u32x4*)(WupT + (size_t)row * UPK + col) = (u32x4){0u, 0u, 0u, 0u}; }
    { float* rowsq = (float*)(ws + WS_ROWSQ); for (int c = gt; c < T; c += NGT) rowsq[c] = 0.f; }
    { bf16_t* PB = (bf16_t*)(ws + WS_PB);
      for (int c = gt; c < T * PLE / 8; c += NGT) { const f32x4 v0 = *(const f32x4*)(a.p + (size_t)c * 8), v1 = *(const f32x4*)(a.p + (size_t)c * 8 + 4);
          u32x4 o; o.x = pk2(v0[0], v0[1]); o.y = pk2(v0[2], v0[3]); o.z = pk2(v1[0], v1[1]); o.w = pk2(v1[2], v1[3]); *(u32x4*)(PB + (size_t)c * 8) = o; } }
    { bf16_t* XN = (bf16_t*)(ws + WS_XN);
      f32x4 g[4];
#pragma unroll
      for (int j = 0; j < 4; ++j) g[j] = *(const f32x4*)(a.g_in + 4 * lane + 256 * j);
      for (int m = gw; m < T; m += NGW) { const float* xr = a.x + (size_t)m * DM + 4 * lane; f32x4 v[4]; float s = 0.f;
#pragma unroll
          for (int j = 0; j < 4; ++j) { v[j] = *(const f32x4*)(xr + 256 * j); s += (v[j][0] * v[j][0] + v[j][1] * v[j][1]) + (v[j][2] * v[j][2] + v[j][3] * v[j][3]); }
          const float rstd = rsqrtf(wave_sum(s) * (1.f / DM) + EPS);
#pragma unroll
          for (int j = 0; j < 4; ++j) { const f32x4 o = v[j] * rstd * g[j]; u32x2 w; w.x = pk2(o[0], o[1]); w.y = pk2(o[2], o[3]); *(u32x2*)(XN + (size_t)m * DM + 4 * lane + 256 * j) = w; } } }
}

__device__ __forceinline__ void late_transposes(const Args& a, LAS unsigned char* lds, int rank_wave, int n_waves, int wave, int lane_) {
    int lane = lane_; asm volatile("" : "+v"(lane));
    bf16_t* WoT = (bf16_t*)(a.ws + WS_WO); bf16_t* WplgT = (bf16_t*)(a.ws + WS_WPLG);
    LAS float* scr = (LAS float*)(lds + wave * 16384);
    constexpr int I_O = (DM / 64) * (DM / 32);
    for (int it = rank_wave; it < 2 * I_O; it += n_waves) {
        if (it < I_O) p0_transpose_item(a.w_o, DM, WoT, DM, 0, 0, scr, it, lane);
        else p0_transpose_item(a.w_plg, DM, WplgT, DM, 0, 0, scr, it - I_O, lane, a.g_pl);
    }
}
struct TokIn { unsigned short q[4][3]; unsigned short k[4][2]; unsigned short kpe; u32x2 cq; unsigned ckv; int pos; };
__device__ __forceinline__ void p4_load(TokIn& t, const bf16_t* PROJ, const bf16_t* RAW, const int* pos, int m, int lane) {
    const bf16_t* pr = PROJ + (size_t)m * PP; const bf16_t* rr = RAW + (size_t)m * UPN;
#pragma unroll
    for (int h = 0; h < NH; ++h) {
#pragma unroll
        for (int i = 0; i < 3; ++i) t.q[h][i] = rr[h * QKD + lane + 64 * i];
#pragma unroll
        for (int i = 0; i < 2; ++i) t.k[h][i] = rr[768 + h * 256 + lane + 64 * i];
    }
    t.kpe = pr[C_KPE + lane]; t.cq = *(const u32x2*)(pr + C_CQ + 4 * lane); t.ckv = *(const unsigned*)(pr + C_CKV + 2 * lane); t.pos = pos[m];
}
__device__ __forceinline__ unsigned short bf16r(float v) { return (unsigned short)(pk2(v, 0.f) & 0xffffu); }
__device__ __forceinline__ void phase4a(const Args& a, int gw, int NGW, int lane_) {
    int lane = lane_; asm volatile("" : "+v"(lane));
    const bf16_t* PROJ = (const bf16_t*)(a.ws + WS_PROJ); const bf16_t* RAW = (const bf16_t*)(a.ws + WS_QKVRAW);
    bf16_t* Q = (bf16_t*)(a.ws + WS_XN); bf16_t* K = (bf16_t*)(a.ws + WS_K);
    const float gq0 = a.g_q[lane], gq1 = a.g_q[lane + 64], gq2 = a.g_q[lane + 128];
    const float gk0 = a.g_k[lane], gk1 = a.g_k[lane + 64], gk2 = a.g_k[lane + 128];
    const int fi = lane & 31; const float inv_freq = 1.0f / powf(10000.0f, (float)(2 * fi) / 64.0f);
    const float qscale = 0.07216878364870322f * 1.4426950408889634f;
    const float sgn = (lane < 32) ? -1.f : 1.f;
    TokIn cur, nxt; int m = gw;
    if (m < T) p4_load(cur, PROJ, RAW, a.pos, m, lane);
    for (; m < T; m += NGW) {
        const int mn = m + NGW; if (mn < T) p4_load(nxt, PROJ, RAW, a.pos, mn, lane);
        const int b = m / SEQ, s = m % SEQ;
        float qv[4][3], kv[4][2]; const float kpe = bf1(cur.kpe);
        float red[11];
        { const float c0 = bflo(cur.cq.x), c1 = bfhi(cur.cq.x), c2 = bflo(cur.cq.y), c3 = bfhi(cur.cq.y), d0 = bflo(cur.ckv), d1 = bfhi(cur.ckv);
          red[0] = (c0 * c0 + c1 * c1) + (c2 * c2 + c3 * c3); red[1] = d0 * d0 + d1 * d1; red[2] = kpe * kpe; }
#pragma unroll
        for (int h = 0; h < NH; ++h) { qv[h][0] = bf1(cur.q[h][0]); qv[h][1] = bf1(cur.q[h][1]); qv[h][2] = bf1(cur.q[h][2]); kv[h][0] = bf1(cur.k[h][0]); kv[h][1] = bf1(cur.k[h][1]);
            red[3 + h] = qv[h][0] * qv[h][0] + qv[h][1] * qv[h][1] + qv[h][2] * qv[h][2]; red[7 + h] = kv[h][0] * kv[h][0] + kv[h][1] * kv[h][1]; }
#pragma unroll
        for (int o = 1; o < 64; o <<= 1) {
#pragma unroll
            for (int e = 0; e < 11; ++e) red[e] += __shfl_xor(red[e], o);
        }
        const float rq = rsqrtf(red[0] * (1.f / QLORA) + EPS), rkv = rsqrtf(red[1] * (1.f / KVLORA) + EPS);
        const float ang = (float)cur.pos * inv_freq; float sn, cs; sincosf(ang, &sn, &cs);
        const float kp = kpe * gk2; const float kpo = __shfl_xor(kp, 32); const float kprope = kp * cs + sgn * kpo * sn;
#pragma unroll
        for (int h = 0; h < NH; ++h) {
            const float rs = rsqrtf(rq * rq * red[3 + h] * (1.f / QKD) + EPS) * rq * qscale;
            const float v0 = qv[h][0] * rs * gq0, v1 = qv[h][1] * rs * gq1, v2 = qv[h][2] * rs * gq2;
            const float o2 = __shfl_xor(v2, 32); const float r2 = v2 * cs + sgn * o2 * sn;
            bf16_t* qo = Q + ((size_t)(b * NH + h) * SEQ + s) * QKD;
            qo[lane] = bf16r(v0); qo[lane + 64] = bf16r(v1); qo[lane + 128] = bf16r(r2);
            const float rk = rsqrtf((rkv * rkv * red[7 + h] + red[2]) * (1.f / QKD) + EPS);
            bf16_t* ko = K + ((size_t)(b * NH + h) * SEQ + s) * QKD;
            ko[lane] = bf16r(kv[h][0] * rkv * rk * gk0); ko[lane + 64] = bf16r(kv[h][1] * rkv * rk * gk1); ko[lane + 128] = bf16r(kprope * rk);
        }
        cur = nxt;
    }
}
__device__ __forceinline__ void phase4b(const Args& a, LAS unsigned char* lds, int tid_) {
    int tid = tid_; asm volatile("" : "+v"(tid));
    const bf16_t* PROJ = (const bf16_t*)(a.ws + WS_PROJ); const bf16_t* RAW = (const bf16_t*)(a.ws + WS_QKVRAW); bf16_t* VT = (bf16_t*)(a.ws + WS_VT);
    constexpr int PITCH = 1040;
    LAS float* rkl = (LAS float*)(lds + 64 * PITCH);
    const int lane = tid & 63, wave = tid >> 6;
    for (int tile = blockIdx.x; tile < T / 64; tile += gridDim.x) {
        const int row0 = tile * 64;
        { float red[8];
#pragma unroll
          for (int e = 0; e < 8; ++e) { const unsigned c = *(const unsigned*)(PROJ + (size_t)(row0 + wave * 8 + e) * PP + C_CKV + 2 * lane); const float d0 = bflo(c), d1 = bfhi(c); red[e] = d0 * d0 + d1 * d1; }
#pragma unroll
          for (int o = 1; o < 64; o <<= 1) {
#pragma unroll
              for (int e = 0; e < 8; ++e) red[e] += __shfl_xor(red[e], o);
          }
#pragma unroll
          for (int e = 0; e < 8; ++e) if (lane == e) rkl[wave * 8 + e] = rsqrtf(red[e] * (1.f / KVLORA) + EPS); }
#pragma unroll
        for (int i = 0; i < 8; ++i) { const int c = tid + 512 * i, tok = c >> 6, rem = c & 63, h = rem >> 4, part = rem & 15;
            const u32x4 v = *(const u32x4*)(RAW + (size_t)(row0 + tok) * UPN + 768 + h * 256 + 128 + part * 8);
            *(LAS u32x4*)(lds + tok * PITCH + (h * 128 + part * 8) * 2) = v; }
        __syncthreads();
        const int b = row0 / SEQ, s0 = row0 % SEQ, ch = tid & 7;
        int key[8];
#pragma unroll
        for (int e = 0; e < 8; ++e) { const int p = ch * 8 + e, q = p & 15; key[e] = 16 * (p >> 4) + 8 * ((q & 7) >> 2) + 4 * (q >> 3) + (q & 3); }
        float rk[8];
#pragma unroll
        for (int e = 0; e < 8; ++e) rk[e] = rkl[key[e]];
#pragma unroll
        for (int i = 0; i < 8; ++i) {
            const int row = (tid >> 3) + 64 * i, h = row >> 7, d = row & 127;
            unsigned w[4];
#pragma unroll
            for (int e = 0; e < 4; ++e) {
                const float lo = bf1(*(const LAS unsigned short*)(lds + key[2 * e] * PITCH + row * 2)) * rk[2 * e], hi = bf1(*(const LAS unsigned short*)(lds + key[2 * e + 1] * PITCH + row * 2)) * rk[2 * e + 1];
                w[e] = pk2(lo, hi);
            }
            *(u32x4*)(VT + ((size_t)(b * NH + h) * VD + d) * SEQ + s0 + ch * 8) = (u32x4){w[0], w[1], w[2], w[3]};
        }
        __syncthreads();
    }
}

#define MFMA32(a, b, c) __builtin_amdgcn_mfma_f32_32x32x16_bf16((a), (b), (c), 0, 0, 0)
constexpr int KTILE = 64 * QKD * 2  , VTILE = VD * 64 * 2  , KRING = 0, VRING = 3 * KTILE;
#define ATT_DMA(gptr, ldsoff) __builtin_amdgcn_global_load_lds((const unsigned*)(gptr), (LAS unsigned*)(lds + (ldsoff)), 16, 0, 0)
#define ATT_ISSUE_K(jt, stage) do { _Pragma("unroll") for (int i_ = 0; i_ < 3; ++i_) ATT_DMA(kg + (size_t)(jt) * KTILE + kgo[i_], KRING + (stage) * KTILE + (wave * 3 + i_) * 1024); } while (0)
#define ATT_ISSUE_V(jt, stage) do { _Pragma("unroll") for (int i_ = 0; i_ < 2; ++i_) ATT_DMA(vg + (size_t)(jt) * 128 + vgo[i_], VRING + (stage) * VTILE + (wave * 2 + i_) * 1024); } while (0)

__device__ __forceinline__ void attn_unit(LAS unsigned char* lds, const bf16_t* Qg, const bf16_t* Kg, const bf16_t* Vtg, bf16_t* Og, int bh, int qb, int tid_, int wave, int lane_) {
    int tid = tid_; asm volatile("" : "+v"(tid));
    const int lane = tid & 63;
    const int rg = wave & 3, kh = wave >> 2, r = lane & 31, hi = lane >> 5;
    const int b = bh >> 2, h = bh & 3;
    const int nt = 2 * (qb + 1);
    const float NEG = -1e30f;
    bf16x8 qf[12];
    { const bf16_t* qp = Qg + ((size_t)bh * SEQ + 128 * qb + 32 * rg + r) * QKD + 8 * hi;
#pragma unroll
      for (int kk = 0; kk < 12; ++kk) qf[kk] = *(const bf16x8*)(qp + 16 * kk); }
    const unsigned char* kg = (const unsigned char*)(Kg + (size_t)bh * SEQ * QKD);
    const unsigned char* vg = (const unsigned char*)(Vtg + (size_t)bh * VD * SEQ);
    unsigned kgo[3], vgo[2];
#pragma unroll
    for (int i = 0; i < 3; ++i) { const int a = (wave * 3 + i) * 1024 + lane * 16, row = a / 384, cp = (a % 384) >> 4, cl = (cp & ~7) | ((cp ^ (row >> 1)) & 7); kgo[i] = (unsigned)(row * 384 + cl * 16); }
#pragma unroll
    for (int i = 0; i < 2; ++i) { const int a = (wave * 2 + i) * 1024 + lane * 16, row = a >> 7, cp = (a & 127) >> 4, cl = (cp ^ (row >> 1)) & 7; vgo[i] = (unsigned)(row * (SEQ * 2) + cl * 16); }
    const int sw = (r >> 1) & 7;
    unsigned kro[4], vro[2];
#pragma unroll
    for (int q = 0; q < 4; ++q) kro[q] = (unsigned)((32 * kh + r) * 384 + (((2 * q + hi) ^ sw) * 16));
#pragma unroll
    for (int s = 0; s < 2; ++s) vro[s] = (unsigned)(VRING + r * 128 + (((4 * kh + 2 * s + hi) ^ sw) * 16));
    f32x16 o[4]; float mrun = NEG, lrun = 0.f;
#pragma unroll
    for (int dt = 0; dt < 4; ++dt)
#pragma unroll
        for (int i = 0; i < 16; ++i) o[dt][i] = 0.f;
    ATT_ISSUE_K(0, 0); ATT_ISSUE_V(0, 0); ATT_ISSUE_K(1, 1);
    ATT_ISSUE_K((2 < nt) ? 2 : nt - 1, 2); ATT_ISSUE_V(1, 1);
    asm volatile("s_waitcnt vmcnt(5)" ::: "memory"); __builtin_amdgcn_s_barrier(); asm volatile("" ::: "memory");
    f32x16 sc, sn;
    {
#pragma unroll
      for (int i = 0; i < 16; ++i) sc[i] = 0.f;
#pragma unroll
      for (int kk = 0; kk < 12; ++kk) { const bf16x8 kf = *(const LAS bf16x8*)(lds + KRING + kro[kk & 3] + (kk >> 2) * 128); sc = MFMA32(kf, qf[kk], sc); if ((kk & 3) == 3) __builtin_amdgcn_sched_barrier(0); } }
    asm volatile("s_waitcnt lgkmcnt(0)" ::: "memory"); __builtin_amdgcn_s_barrier(); asm volatile("" ::: "memory");
    const float NINF = -__builtin_inff();
    int s0 = 0, s1 = 1, s2 = 2;
    for (int j = 0; j < nt; ++j) {
        const int relc = 64 * (j - 2 * qb) + 32 * kh - 32 * rg;
        const int j3 = (j + 3 < nt) ? j + 3 : nt - 1, j2 = (j + 2 < nt) ? j + 2 : nt - 1;
        const LAS unsigned char* kb = lds + KRING + s1 * KTILE;
        const LAS unsigned char* vb = lds + s0 * VTILE;
        if (relc >= 0) {
            const int thr = (relc == 0) ? r : -1;
#pragma unroll
            for (int i = 0; i < 16; ++i) { const int key = (i & 3) + 8 * (i >> 2) + 4 * hi; if (key > thr) sc[i] = NINF; }
        }
#define ATT_KRD(dst, g) do { _Pragma("unroll") for (int q_ = 0; q_ < 4; ++q_) dst[q_] = *(const LAS bf16x8*)(kb + kro[q_] + (g) * 128); } while (0)
        bf16x8 fa[4], fb[4];
        ATT_KRD(fa, 0); ATT_KRD(fb, 1);
#pragma unroll
        for (int i = 0; i < 16; ++i) sn[i] = 0.f;
        float mx = sc[0];
#pragma unroll
        for (int i = 1; i < 16; ++i) mx = fmaxf(mx, sc[i]);
        mx = max_xor32(mx);
        __builtin_amdgcn_sched_barrier(0);
#pragma unroll
        for (int q = 0; q < 4; ++q) sn = MFMA32(fa[q], qf[q], sn);
        ATT_KRD(fa, 2);
        __builtin_amdgcn_sched_barrier(0);
        if (__builtin_amdgcn_ballot_w64(mx > mrun + 8.f) != 0ull) {
            const float mnew = fmaxf(mrun, mx); const float alpha = __builtin_amdgcn_exp2f(mrun - mnew); mrun = mnew; lrun *= alpha;
#pragma unroll
            for (int dt = 0; dt < 4; ++dt) o[dt] = o[dt] * alpha;
        }
        float ps = 0.f; u32x4 p0, p1;
#pragma unroll
        for (int q = 0; q < 4; ++q) sn = MFMA32(fb[q], qf[4 + q], sn);
#pragma unroll
        for (int i = 0; i < 8; ++i) { sc[i] = __builtin_amdgcn_exp2f(sc[i] - mrun); ps += sc[i]; }
        p0.x = pk2(sc[0], sc[1]); p0.y = pk2(sc[2], sc[3]); p0.z = pk2(sc[4], sc[5]); p0.w = pk2(sc[6], sc[7]);
        __builtin_amdgcn_sched_barrier(0);
        ATT_ISSUE_K(j3, s0);
        __builtin_amdgcn_sched_barrier(0);
        fb[0] = *(const LAS bf16x8*)(vb + vro[0]); fb[1] = *(const LAS bf16x8*)(vb + vro[1]); fb[2] = *(const LAS bf16x8*)(vb + vro[0] + 4096); fb[3] = *(const LAS bf16x8*)(vb + vro[1] + 4096);
#pragma unroll
        for (int q = 0; q < 4; ++q) sn = MFMA32(fa[q], qf[8 + q], sn);
#pragma unroll
        for (int i = 8; i < 16; ++i) { sc[i] = __builtin_amdgcn_exp2f(sc[i] - mrun); ps += sc[i]; }
        p1.x = pk2(sc[8], sc[9]); p1.y = pk2(sc[10], sc[11]); p1.z = pk2(sc[12], sc[13]); p1.w = pk2(sc[14], sc[15]);
        lrun += ps;
        __builtin_amdgcn_sched_barrier(0);
        ATT_ISSUE_V(j2, s2);
        __builtin_amdgcn_sched_barrier(0);
        fa[0] = *(const LAS bf16x8*)(vb + vro[0] + 8192); fa[1] = *(const LAS bf16x8*)(vb + vro[1] + 8192); fa[2] = *(const LAS bf16x8*)(vb + vro[0] + 12288); fa[3] = *(const LAS bf16x8*)(vb + vro[1] + 12288);
        { const bf16x8 pf0 = __builtin_bit_cast(bf16x8, p0), pf1 = __builtin_bit_cast(bf16x8, p1);
          o[0] = MFMA32(fb[0], pf0, o[0]); o[0] = MFMA32(fb[1], pf1, o[0]); o[1] = MFMA32(fb[2], pf0, o[1]); o[1] = MFMA32(fb[3], pf1, o[1]);
          __builtin_amdgcn_sched_barrier(0);
          o[2] = MFMA32(fa[0], pf0, o[2]); o[2] = MFMA32(fa[1], pf1, o[2]); o[3] = MFMA32(fa[2], pf0, o[3]); o[3] = MFMA32(fa[3], pf1, o[3]); }
        asm volatile("s_waitcnt vmcnt(5) lgkmcnt(0)" ::: "memory"); __builtin_amdgcn_s_barrier(); asm volatile("" ::: "memory");
        sc = sn;
        { const int t = s0; s0 = s1; s1 = s2; s2 = t; }
    }
    asm volatile("s_waitcnt vmcnt(0) lgkmcnt(0)" ::: "memory"); __builtin_amdgcn_s_barrier(); asm volatile("" ::: "memory");
    LAS float* cs = (LAS float*)(lds + rg * (66 * 64 * 4)) + lane;
    if (kh == 1) {
#pragma unroll
        for (int dt = 0; dt < 4; ++dt)
#pragma unroll
            for (int i = 0; i < 16; ++i) cs[(dt * 16 + i) * 64] = o[dt][i];
        cs[64 * 64] = mrun; cs[65 * 64] = lrun;
    }
    __syncthreads();
    if (kh == 0) {
        const float m1 = cs[64 * 64], l1 = cs[65 * 64];
        const float mf = fmaxf(mrun, m1), a0 = __builtin_amdgcn_exp2f(mrun - mf), a1 = __builtin_amdgcn_exp2f(m1 - mf);
        float lt = lrun * a0 + l1 * a1; lt += __shfl_xor(lt, 32);
        const float inv = 1.f / lt;
        bf16_t* op = Og + ((size_t)b * SEQ + 128 * qb + 32 * rg + r) * AW + h * VD + 4 * hi;
#pragma unroll
        for (int dt = 0; dt < 4; ++dt)
#pragma unroll
            for (int g = 0; g < 4; ++g) {
                float v[4];
#pragma unroll
                for (int e = 0; e < 4; ++e) v[e] = (o[dt][4 * g + e] * a0 + cs[(dt * 16 + 4 * g + e) * 64] * a1) * inv;
                u32x2 w; w.x = pk2(v[0], v[1]); w.y = pk2(v[2], v[3]);
                *(u32x2*)(op + 32 * dt + 8 * g) = w;
            }
    }
    __syncthreads();
}

__device__ __forceinline__ void unpack8(const u32x4 v, float (&f)[8]) { f[0] = bflo(v.x); f[1] = bfhi(v.x); f[2] = bflo(v.y); f[3] = bfhi(v.y); f[4] = bflo(v.z); f[5] = bfhi(v.z); f[6] = bflo(v.w); f[7] = bfhi(v.w); }
struct Tok6 { u32x4 o, za, g, pr; };
__device__ __forceinline__ void p6_load(Tok6& t, const bf16_t* PROJ, const bf16_t* O, int m, int c0) {
    const bf16_t* pr = PROJ + (size_t)m * PP;
    t.o = *(const u32x4*)(O + (size_t)m * AW + c0); t.za = *(const u32x4*)(pr + C_ZA + c0); t.g = *(const u32x4*)(pr + C_G + c0); t.pr = *(const u32x4*)(pr + C_PR + c0);
}
__device__ __forceinline__ void phase6(const Args& a, int gw, int NGW, int lane_) {
    int lane = lane_; asm volatile("" : "+v"(lane));
    const bf16_t* PROJ = (const bf16_t*)(a.ws + WS_PROJ); const bf16_t* O = (const bf16_t*)(a.ws + WS_QKVRAW); bf16_t* Y = (bf16_t*)(a.ws + WS_XN);
    const int c0 = 8 * lane;
    float goa[8], goc[8], w0[8], w1[8], w2[8];
#pragma unroll
    for (int e = 0; e < 8; ++e) { goa[e] = a.g_oa[c0 + e]; goc[e] = a.g_oc[c0 + e]; w0[e] = a.conv_w[c0 + e]; w1[e] = a.conv_w[CW + c0 + e]; w2[e] = a.conv_w[2 * CW + c0 + e]; }
    for (int ch = gw; ch < T / 8; ch += NGW) {
        const int m0 = ch * 8, s0 = m0 % SEQ;
        float pm2[8], pm1[8];
        if (s0 >= 2) { unpack8(*(const u32x4*)(PROJ + (size_t)(m0 - 1) * PP + C_PR + c0), pm1); unpack8(*(const u32x4*)(PROJ + (size_t)(m0 - 2) * PP + C_PR + c0), pm2); }
        else {
#pragma unroll
            for (int e = 0; e < 8; ++e) { pm1[e] = 0.f; pm2[e] = 0.f; }
        }
        Tok6 cur, nxt; p6_load(cur, PROJ, O, m0, c0);
#pragma unroll 1
        for (int i = 0; i < 8; ++i) {
            const int m = m0 + i;
            if (i < 7) p6_load(nxt, PROJ, O, m + 1, c0);
            float ov[8], za[8], gg[8], p0[8], v[8], u[8];
            unpack8(cur.o, ov); unpack8(cur.za, za); unpack8(cur.g, gg); unpack8(cur.pr, p0);
            float ss = 0.f, s2 = 0.f;
#pragma unroll
            for (int e = 0; e < 8; ++e) { v[e] = ov[e] * silu_f(za[e]); ss += v[e] * v[e];
                u[e] = gg[e] * (w2[e] * p0[e] + w1[e] * pm1[e] + w0[e] * pm2[e]); s2 += u[e] * u[e]; pm2[e] = pm1[e]; pm1[e] = p0[e]; }
#pragma unroll
            for (int o = 1; o < 64; o <<= 1) { ss += __shfl_xor(ss, o); s2 += __shfl_xor(s2, o); }
            const float rs = rsqrtf(ss * (1.f / AW) + EPS), rc = rsqrtf(s2 * (1.f / CW) + EPS);
            u32x4 w; w.x = pk2(v[0] * rs * goa[0], v[1] * rs * goa[1]); w.y = pk2(v[2] * rs * goa[2], v[3] * rs * goa[3]); w.z = pk2(v[4] * rs * goa[4], v[5] * rs * goa[5]); w.w = pk2(v[6] * rs * goa[6], v[7] * rs * goa[7]);
            *(u32x4*)(Y + (size_t)m * DM + c0) = w;
            w.x = pk2(u[0] * rc * goc[0], u[1] * rc * goc[1]); w.y = pk2(u[2] * rc * goc[2], u[3] * rc * goc[3]); w.z = pk2(u[4] * rc * goc[4], u[5] * rc * goc[5]); w.w = pk2(u[6] * rc * goc[6], u[7] * rc * goc[7]);
            *(u32x4*)(Y + (size_t)m * DM + AW + c0) = w;
            cur = nxt;
        }
    }
}

#define XB_TMO      128
#define XB_XCNT(j)  (256  + 64 * (j))
#define XB_XSUB(j)  (1280 + 64 * (j))
#define XB_XGEN(j)  (2304 + 64 * (j))
#define XB_TOP      3328
#define XB_TOPGEN   3392
#define XCD_BAR_WORDS 3456
#define XB_SPIN_CAP (1u << 18)

__device__ __forceinline__ unsigned xb_ld(unsigned* p)              { return __hip_atomic_load(p, __ATOMIC_RELAXED, __HIP_MEMORY_SCOPE_AGENT); }
__device__ __forceinline__ unsigned xb_add(unsigned* p, unsigned v) { return __hip_atomic_fetch_add(p, v, __ATOMIC_RELAXED, __HIP_MEMORY_SCOPE_AGENT); }
__device__ __forceinline__ unsigned xb_xcc_id() { return (unsigned)__builtin_amdgcn_s_getreg((3 << 11) | 20) & 0xFu; }
#define XB_SPIN(cond, bar) do { unsigned _sp = 0; while (cond) { __builtin_amdgcn_s_sleep(1); \
    if ((++_sp & 255u) == 0u) { if (xb_ld(&(bar)[XB_TMO])) break; if (_sp > XB_SPIN_CAP) { atomicAdd(&(bar)[XB_TMO], 1u); break; } } } } while (0)

struct XcdBarrier {
    unsigned* bar; unsigned x;
    volatile LAS unsigned* st;
};

__device__ __forceinline__ XcdBarrier xcd_barrier_post(unsigned* bar, volatile LAS unsigned* st) {
    XcdBarrier b; b.bar = bar; b.x = xb_xcc_id(); b.st = st;
    if (threadIdx.x == 0) (void)xb_add(&bar[XB_XCNT(b.x)], 1u);
    return b;
}
__device__ __forceinline__ void xcd_barrier_complete(unsigned* bar, unsigned x, unsigned& nloc, unsigned& nx) {
    const unsigned G = gridDim.x * gridDim.y * gridDim.z;
    unsigned sum, cnt, mine, sp = 0u;
    for (;;) {
        sum = 0u; cnt = 0u; mine = 0u;
#pragma unroll
        for (unsigned j = 0; j < 16; ++j) { const unsigned c = xb_ld(&bar[XB_XCNT(j)]); sum += c; cnt += (c > 0u) ? 1u : 0u; mine = (j == x) ? c : mine; }
        if (sum == G) break;
        __builtin_amdgcn_s_sleep(1);
        if ((++sp & 255u) == 0u) { if (xb_ld(&bar[XB_TMO])) break; if (sp > XB_SPIN_CAP) { atomicAdd(&bar[XB_TMO], 1u); break; } }
    }
    nloc = mine > 0u ? mine : 1u; nx = cnt > 0u ? cnt : 1u;
}

__device__ __forceinline__ void xcd_barrier(const XcdBarrier& b) {
    asm volatile("s_waitcnt vmcnt(0)" ::: "memory");
    __syncthreads();
    if (threadIdx.x == 0) {
        unsigned* bar = b.bar;
        __builtin_amdgcn_s_waitcnt(0);
        unsigned nloc = b.st[0], nx = b.st[1];
        if (nloc == 0u) { xcd_barrier_complete(bar, b.x, nloc, nx); b.st[0] = nloc; b.st[1] = nx; }
        const unsigned old = xb_add(&bar[XB_XSUB(b.x)], 1u);
        const unsigned gen = old / nloc;
        if (old + 1u == (gen + 1u) * nloc) {
            __builtin_amdgcn_fence(__ATOMIC_RELEASE, "agent");
            asm volatile("s_waitcnt vmcnt(0)" ::: "memory");
            const unsigned og = xb_add(&bar[XB_TOP], 1u);
            const unsigned tg = og / nx;
            if (og + 1u == (tg + 1u) * nx) xb_add(&bar[XB_TOPGEN], 1u);
            else XB_SPIN(xb_ld(&bar[XB_TOPGEN]) == tg, bar);
            __builtin_amdgcn_fence(__ATOMIC_ACQUIRE, "agent");
            xb_add(&bar[XB_XGEN(b.x)], 1u);
            asm volatile("s_waitcnt vmcnt(0)" ::: "memory");
        } else {
            XB_SPIN(xb_ld(&bar[XB_XGEN(b.x)]) == gen, bar);
            __builtin_amdgcn_fence(__ATOMIC_ACQUIRE, "agent");
            asm volatile("s_waitcnt vmcnt(0)" ::: "memory");
        }
    }
    __syncthreads();
}

constexpr size_t WS_BAR = 15 * MiB;
#define XB_EXIT XCD_BAR_WORDS
__device__ unsigned g_barw[XCD_BAR_WORDS + 64];
constexpr int LDS_BYTES = 132096;

__global__ void __launch_bounds__(NTHREADS, 2) fwd_megakernel(Args a) {
    extern __shared__ __attribute__((aligned(16))) unsigned char lds_raw[];
    LAS unsigned char* lds = (LAS unsigned char*)lds_raw;
    cg::grid_group grid = cg::this_grid();
    const int tid = threadIdx.x, lane = tid & 63, wave = __builtin_amdgcn_readfirstlane(tid >> 6);
    const int G = gridDim.x, gw = blockIdx.x * NWAVES + wave, NGW = G * NWAVES;
    unsigned char* ws = a.ws;
    bf16_t* XN = (bf16_t*)(ws + WS_XN); bf16_t* PROJ = (bf16_t*)(ws + WS_PROJ); bf16_t* RAW = (bf16_t*)(ws + WS_QKVRAW);

    unsigned* barw = g_barw;
    if (tid < 2) ((volatile LAS unsigned*)(lds + 131072))[tid] = 0u;
    __syncthreads();
    const XcdBarrier bar = xcd_barrier_post(barw, (volatile LAS unsigned*)(lds + 131072));
    if (a.never) grid.sync();
    phase0(a, lds, gw, NGW, wave, lane);
    xcd_barrier(bar);
#define G1_PL() { pg8::Gemm g{(const bf16_t*)(ws + WS_PB), (const bf16_t*)(ws + WS_WPL), T, DM, PLE, PLE}; pg8::StaticOrder S; S.init(T, DM, G, (int)blockIdx.x); \
      pg8::EpiPl E{(bf16_t*)(ws + WS_PL), DM}; pg8::gemm_phase<pg8::EpiPl, pg8::StaticOrder, true, true>(lds, g, S, E); }
    if (blockIdx.x & 1) G1_PL();
    { pg8::Gemm g{XN, (const bf16_t*)(ws + WS_WIN), T, 1024, DM, DM}; pg8::StaticOrder S; S.init(T, 1024, G, (int)blockIdx.x);
      pg8::EpiBf16<0> E{PROJ, PP};
      pg8::gemm_phase<pg8::EpiBf16<0>, pg8::StaticOrder, true, true>(lds, g, S, E); }
    { pg8::Gemm g{XN, (const bf16_t*)(ws + WS_WIN) + (size_t)1024 * DM, T, 2048, DM, DM}; pg8::StaticOrder S; S.init(T, 2048, G, (int)blockIdx.x);
      pg8::EpiProjB E{PROJ, PP};
      pg8::gemm_phase<pg8::EpiProjB, pg8::StaticOrder, true, true>(lds, g, S, E); }
    if (!(blockIdx.x & 1)) G1_PL();
    xcd_barrier(bar);
    { pg8::Gemm g{PROJ, (const bf16_t*)(ws + WS_WUP), T, UPN, UPK, PP}; pg8::StaticOrder S; S.init(T, UPN, G, (int)blockIdx.x);
      pg8::EpiBf16<0> E{RAW, UPN};
      pg8::gemm_phase<pg8::EpiBf16<0>, pg8::StaticOrder, true, true>(lds, g, S, E); }
    { const int nunits = (T / 256) * (UPN / 256), idle0 = (nunits - G > 0 && nunits - G < G) ? nunits - G : 0;
      if ((int)blockIdx.x >= idle0) late_transposes(a, lds, ((int)blockIdx.x - idle0) * NWAVES + wave, (G - idle0) * NWAVES, wave, lane); }
    xcd_barrier(bar);
    phase4a(a, gw, NGW, lane);
    phase4b(a, lds, tid);
    xcd_barrier(bar);
    { const bf16_t* Qg = XN; const bf16_t* Kg = (const bf16_t*)(ws + WS_K); const bf16_t* Vtg = (const bf16_t*)(ws + WS_VT); bf16_t* Og = RAW;
      for (int c = blockIdx.x; c < 256; c += G) { const int bh = c & 7, pi = c >> 3;
          attn_unit(lds, Qg, Kg, Vtg, Og, bh, 63 - pi, tid, wave, lane);
          attn_unit(lds, Qg, Kg, Vtg, Og, bh, pi, tid, wave, lane); } }
    xcd_barrier(bar);
    phase6(a, gw, NGW, lane);
    xcd_barrier(bar);
    { pg8::Gemm g{XN, (const bf16_t*)(ws + WS_WO), T, DM, DM, DM}; pg8::StaticOrder S; S.init(T, DM, G, (int)blockIdx.x);
      pg8::EpiX1 E{a.x, a.out, (bf16_t*)(ws + WS_X1B), (float*)(ws + WS_ROWSQ), DM};
      pg8::gemm_phase<pg8::EpiX1, pg8::StaticOrder, true, true>(lds, g, S, E); }
    xcd_barrier(bar);
    { pg8::Gemm g{(const bf16_t*)(ws + WS_X1B), (const bf16_t*)(ws + WS_WPLG), T, DM, DM, DM}; pg8::StaticOrder S; S.init(T, DM, G, (int)blockIdx.x);
      pg8::EpiGateOut E{(const bf16_t*)(ws + WS_PL), (const bf16_t*)(ws + WS_X1B), a.out, (const float*)(ws + WS_ROWSQ), DM, EPS};
      pg8::gemm_phase<pg8::EpiGateOut, pg8::StaticOrder, true, true>(lds, g, S, E); }
    __syncthreads();
    { LAS unsigned* flag = (LAS unsigned*)(lds + 131072 + 16);
      if (tid == 0) flag[0] = (xb_add(&barw[XB_EXIT], 1u) == (unsigned)G - 1u) ? 1u : 0u;
      __syncthreads();
      if (flag[0]) { for (int i = tid; i < XCD_BAR_WORDS + 64; i += NTHREADS) __hip_atomic_store(&barw[i], 0u, __ATOMIC_RELAXED, __HIP_MEMORY_SCOPE_AGENT); } }
}

extern "C" void kernel_launch(void* const* d_in, const int* in_sizes, int n_in, void* d_out, int out_size, void* d_ws, size_t ws_size, hipStream_t stream) {
    static int grid = 0;
    if (grid == 0) {
        if (n_in != 18 || in_sizes[0] != T * DM || out_size != T * DM || ws_size < WS_END) { fprintf(stderr, "kernel_launch: unexpected shapes (n_in %d, in0 %d, out %d, ws %zu)\n", n_in, n_in > 0 ? in_sizes[0] : -1, out_size, ws_size); grid = -1; return; }
        int dev = 0, cus = 0, per_cu = 0;
        hipGetDevice(&dev); hipDeviceGetAttribute(&cus, hipDeviceAttributeMultiprocessorCount, dev);
        if (hipFuncSetAttribute((const void*)fwd_megakernel, hipFuncAttributeMaxDynamicSharedMemorySize, LDS_BYTES) != hipSuccess) { fprintf(stderr, "kernel_launch: hipFuncSetAttribute failed\n"); }
        if (hipOccupancyMaxActiveBlocksPerMultiprocessor(&per_cu, (const void*)fwd_megakernel, NTHREADS, LDS_BYTES) != hipSuccess || per_cu < 1) { fprintf(stderr, "kernel_launch: occupancy query says %d\n", per_cu); per_cu = 1; }
        (void)hipGetLastError();
        grid = cus * (per_cu > 1 ? 1 : per_cu);
        if (grid <= 0) grid = 256;
    }
    if (grid < 0) return;
    Args a{};
    a.x = (const float*)d_in[0]; a.p = (const float*)d_in[1]; a.pos = (const int*)d_in[2]; a.g_in = (const float*)d_in[3]; a.w_in = (const float*)d_in[4];
    a.g_cq = (const float*)d_in[5]; a.w_uq = (const float*)d_in[6]; a.g_ckv = (const float*)d_in[7]; a.w_ukv = (const float*)d_in[8];
    a.g_q = (const float*)d_in[9]; a.g_k = (const float*)d_in[10]; a.conv_w = (const float*)d_in[11]; a.g_oa = (const float*)d_in[12]; a.g_oc = (const float*)d_in[13];
    a.w_o = (const float*)d_in[14]; a.w_pl = (const float*)d_in[15]; a.w_plg = (const float*)d_in[16]; a.g_pl = (const float*)d_in[17];
    a.out = (float*)d_out; a.ws = (unsigned char*)d_ws;
    void* args[] = {&a};
    hipError_t e = hipLaunchCooperativeKernel((const void*)fwd_megakernel, dim3(grid), dim3(NTHREADS), args, LDS_BYTES, stream);
    if (e != hipSuccess) fprintf(stderr, "cooperative launch failed: %s (grid %d)\n", hipGetErrorString(e), grid);
}
```

```cpp
#include <hip/hip_runtime.h>
#include <hip/hip_cooperative_groups.h>
#include <cstdio>
#include <cstdint>
namespace cg = cooperative_groups;

typedef __bf16 bf16x2v_t __attribute__((ext_vector_type(2)));
typedef float f32x2_t __attribute__((ext_vector_type(2)));
__device__ __forceinline__ unsigned pk2(float a, float b) { f32x2_t v = {a, b}; bf16x2v_t r = __builtin_convertvector(v, bf16x2v_t); return __builtin_bit_cast(unsigned, r); }
__device__ __forceinline__ float bflo(unsigned u) { return __uint_as_float(u << 16); }
__device__ __forceinline__ float bfhi(unsigned u) { return __uint_as_float(u & 0xffff0000u); }
__device__ __forceinline__ float bf1(unsigned short u) { return __uint_as_float(((unsigned)u) << 16); }

namespace pg8 {
#define PG8_LAS __attribute__((address_space(3)))
typedef unsigned short bf16_t;
typedef short bf16x8 __attribute__((ext_vector_type(8)));
typedef float f32x4 __attribute__((ext_vector_type(4)));
typedef unsigned u32x4 __attribute__((ext_vector_type(4)));
constexpr int BM = 256, BK = 64, HALF = 128, HTB = HALF * BK * 2  , STAGE_BYTES = 8 * HTB, NXCD = 8, WGM = 8;

__host__ __device__ __forceinline__ int lds_byte(int r, int c) { const int st = (r >> 4) * 2 + (c >> 5), rr = r & 15, cc = c & 31, ob = rr * 64 + cc * 2; return st * 1024 + (ob ^ (((ob >> 9) & 1) << 5)); }
__host__ __device__ __forceinline__ void stage_rc(int b, int& R, int& C) { const int st = b / 1024, sb = b % 1024, swz = sb ^ (((sb >> 9) & 1) << 5); R = (st >> 1) * 16 + swz / 64; C = (st & 1) * 32 + (swz % 64) / 2; }
__host__ __device__ __forceinline__ int perm32(int rho) { const int n = rho >> 4, i = rho & 15; return 8 * (i >> 2) + 4 * n + (i & 3); }

struct Unit { int pm, pn; };
struct Gemm { const bf16_t* A; const bf16_t* Bt; int M, N, K, lda; };

struct StaticOrder {
    int nM, nN, nwg, G, c;
    __host__ __device__ void init(int M, int N, int G_, int c_) { nM = M / BM; nN = N / BM; nwg = nM * nN; G = G_; c = c_; }
    __host__ __device__ bool next(int i, Unit& u) const {
        const long L = (long)i * G + c; if (L >= nwg) return false;
        int wgid = (int)L; { const int q = nwg / NXCD, r = nwg % NXCD, xcd = wgid % NXCD, off = wgid / NXCD; wgid = (xcd < r ? xcd * (q + 1) : r * (q + 1) + (xcd - r) * q) + off; }
        const int nig = WGM * nN, gid = wgid / nig, fm = gid * WGM, gsz = (nM - fm) < WGM ? (nM - fm) : WGM;
        u.pm = fm + ((wgid % nig) % gsz); u.pn = (wgid % nig) / gsz; return true;
    }
    __device__ __forceinline__ void a_ready(const Unit&) const {}
    __device__ __forceinline__ void done(const Unit&) const {}
};


template <int ACT  > struct EpiBf16 {
    static constexpr bool PERM = true, AFTER_DRAIN = false;
    bf16_t* O; int ldc;
    __device__ __forceinline__ void operator()(const f32x4 (&acc)[2][2][4][2], const Unit& u, int wr, int wc, int fr, int fq) const {
        const int row0 = u.pm * BM + wr * 64 + fr; const int col0 = u.pn * BM + wc * 32 + 8 * fq;
#pragma unroll
        for (int ai = 0; ai < 2; ++ai)
#pragma unroll
            for (int m = 0; m < 4; ++m) { bf16_t* rowp = O + (size_t)(row0 + ai * HALF + m * 16) * ldc + col0;
#pragma unroll
                for (int bj = 0; bj < 2; ++bj) { f32x4 v0 = acc[ai][bj][m][0], v1 = acc[ai][bj][m][1];
                    if (ACT == 1) {
#pragma unroll
                        for (int e = 0; e < 4; ++e) { v0[e] = 1.f / (1.f + __expf(-v0[e])); v1[e] = 1.f / (1.f + __expf(-v1[e])); }
                    }
                    if (ACT == 2) {
                        const bool act = (u.pn >= 2);
#pragma unroll
                        for (int e = 0; e < 4; ++e) { const float s0 = v0[e] * __builtin_amdgcn_rcpf(1.f + __builtin_amdgcn_exp2f(-1.4426950408889634f * v0[e])), s1 = v1[e] * __builtin_amdgcn_rcpf(1.f + __builtin_amdgcn_exp2f(-1.4426950408889634f * v1[e]));
                            v0[e] = act ? s0 : v0[e]; v1[e] = act ? s1 : v1[e]; }
                    }
                    u32x4 w; w.x = pk2(v0[0], v0[1]); w.y = pk2(v0[2], v0[3]); w.z = pk2(v1[0], v1[1]); w.w = pk2(v1[2], v1[3]);
                    *(u32x4*)(rowp + bj * HALF) = w; } }
    }
};
struct EpiProjB {
    static constexpr bool PERM = false, AFTER_DRAIN = false;
    bf16_t* O; int ldc;
    __device__ __forceinline__ void operator()(const f32x4 (&acc)[2][2][4][2], const Unit& u, int wr, int wc, int fr, int fq) const {
        typedef unsigned u32x2 __attribute__((ext_vector_type(2)));
        const int row0 = u.pm * BM + wr * 64 + fr;
        const int ch0 = u.pn * 64 + 16 * wc + 4 * fq;
#pragma unroll
        for (int ai = 0; ai < 2; ++ai)
#pragma unroll
            for (int m = 0; m < 4; ++m) { bf16_t* rowp = O + (size_t)(row0 + ai * HALF + m * 16) * ldc + ch0;
                const f32x4 cb = acc[ai][0][m][0], zc = acc[ai][0][m][1], cc = acc[ai][1][m][0], cx = acc[ai][1][m][1]; f32x4 g, pr;
#pragma unroll
                for (int e = 0; e < 4; ++e) { g[e] = cb[e] * zc[e] * __builtin_amdgcn_rcpf(1.f + __builtin_amdgcn_exp2f(-1.4426950408889634f * zc[e])); pr[e] = cc[e] * cx[e]; }
                u32x2 w; w.x = pk2(g[0], g[1]); w.y = pk2(g[2], g[3]); *(u32x2*)(rowp + 1024) = w;
                w.x = pk2(pr[0], pr[1]); w.y = pk2(pr[2], pr[3]); *(u32x2*)(rowp + 1536) = w; }
    }
};
struct EpiX1 {
    static constexpr bool PERM = true, AFTER_DRAIN = false;
    const float* base; float* out; bf16_t* xb; float* rowsq; int ldc;
    __device__ __forceinline__ void operator()(const f32x4 (&acc)[2][2][4][2], const Unit& u, int wr, int wc, int fr, int fq) const {
        const int row0 = u.pm * BM + wr * 64 + fr; const int col0 = u.pn * BM + wc * 32 + 8 * fq;
#pragma unroll
        for (int ai = 0; ai < 2; ++ai)
#pragma unroll
            for (int m = 0; m < 4; ++m) { const int row = row0 + ai * HALF + m * 16; const size_t off = (size_t)row * ldc + col0; float s = 0.f;
#pragma unroll
                for (int bj = 0; bj < 2; ++bj) { const size_t o2 = off + bj * HALF;
                    const f32x4 v0 = *(const f32x4*)(base + o2) + acc[ai][bj][m][0], v1 = *(const f32x4*)(base + o2 + 4) + acc[ai][bj][m][1];
                    u32x4 w; w.x = pk2(v0[0], v0[1]); w.y = pk2(v0[2], v0[3]); w.z = pk2(v1[0], v1[1]); w.w = pk2(v1[2], v1[3]); *(u32x4*)(xb + o2) = w;
                    s += ((v0[0] * v0[0] + v0[1] * v0[1]) + (v0[2] * v0[2] + v0[3] * v0[3])) + ((v1[0] * v1[0] + v1[1] * v1[1]) + (v1[2] * v1[2] + v1[3] * v1[3])); }
                s += __shfl_xor(s, 16); s += __shfl_xor(s, 32);
                if (fq == 0) atomicAdd(rowsq + row, s);
                if (m & 1) asm volatile("" ::: "memory"); }
    }
};
struct EpiPl {
    static constexpr bool PERM = true, AFTER_DRAIN = false;
    bf16_t* pl; int ldc;
    __device__ __forceinline__ void operator()(const f32x4 (&acc)[2][2][4][2], const Unit& u, int wr, int wc, int fr, int fq) const {
        const int row0 = u.pm * BM + wr * 64 + fr; const int col0 = u.pn * BM + wc * 32 + 8 * fq;
#pragma unroll
        for (int ai = 0; ai < 2; ++ai)
#pragma unroll
            for (int m = 0; m < 4; ++m) { const size_t off = (size_t)(row0 + ai * HALF + m * 16) * ldc + col0;
#pragma unroll
                for (int bj = 0; bj < 2; ++bj) { const f32x4 v0 = acc[ai][bj][m][0], v1 = acc[ai][bj][m][1];
                    u32x4 w; w.x = pk2(v0[0], v0[1]); w.y = pk2(v0[2], v0[3]); w.z = pk2(v1[0], v1[1]); w.w = pk2(v1[2], v1[3]); *(u32x4*)(pl + off + bj * HALF) = w; } }
    }
};
struct EpiGateOut {
    static constexpr bool PERM = true, AFTER_DRAIN = false;
    const bf16_t* pl; const bf16_t* xb; float* out; const float* rowsq; int ldc; float eps;
    __device__ __forceinline__ void operator()(const f32x4 (&acc)[2][2][4][2], const Unit& u, int wr, int wc, int fr, int fq) const {
        const int row0 = u.pm * BM + wr * 64 + fr; const int col0 = u.pn * BM + wc * 32 + 8 * fq;
#pragma unroll
        for (int ai = 0; ai < 2; ++ai)
#pragma unroll
            for (int m = 0; m < 4; ++m) { const int row = row0 + ai * HALF + m * 16; const size_t off = (size_t)row * ldc + col0;
                const float nrl = -1.4426950408889634f * __builtin_amdgcn_rsqf(__hip_atomic_load(rowsq + row, __ATOMIC_RELAXED, __HIP_MEMORY_SCOPE_AGENT) * (1.f / (float)ldc) + eps);
#pragma unroll
                for (int bj = 0; bj < 2; ++bj) { const size_t o2 = off + bj * HALF; const u32x4 xw = *(const u32x4*)(xb + o2), g = *(const u32x4*)(pl + o2);
                    f32x4 b0, b1, p0, p1;
                    b0[0] = __uint_as_float(xw.x << 16); b0[1] = __uint_as_float(xw.x & 0xffff0000u); b0[2] = __uint_as_float(xw.y << 16); b0[3] = __uint_as_float(xw.y & 0xffff0000u);
                    b1[0] = __uint_as_float(xw.z << 16); b1[1] = __uint_as_float(xw.z & 0xffff0000u); b1[2] = __uint_as_float(xw.w << 16); b1[3] = __uint_as_float(xw.w & 0xffff0000u);
                    p0[0] = __uint_as_float(g.x << 16); p0[1] = __uint_as_float(g.x & 0xffff0000u); p0[2] = __uint_as_float(g.y << 16); p0[3] = __uint_as_float(g.y & 0xffff0000u);
                    p1[0] = __uint_as_float(g.z << 16); p1[1] = __uint_as_float(g.z & 0xffff0000u); p1[2] = __uint_as_float(g.w << 16); p1[3] = __uint_as_float(g.w & 0xffff0000u);
                    f32x4 s0, s1;
#pragma unroll
                    for (int e = 0; e < 4; ++e) { s0[e] = __builtin_amdgcn_rcpf(1.f + __builtin_amdgcn_exp2f(nrl * acc[ai][bj][m][0][e])); s1[e] = __builtin_amdgcn_rcpf(1.f + __builtin_amdgcn_exp2f(nrl * acc[ai][bj][m][1][e])); }
                    *(f32x4*)(out + o2) = b0 + s0 * p0; *(f32x4*)(out + o2 + 4) = b1 + s1 * p1; }
                if (m & 1) asm volatile("" ::: "memory"); }
    }
};

template <class Epi, class Sched, bool ALIGN_EPI = false, bool SP2 = false>
__device__ __forceinline__ void gemm_phase(PG8_LAS unsigned char* lds, const Gemm g, const Sched& S, const Epi& E) {
    int tid_ = threadIdx.x; asm volatile("" : "+v"(tid_));
    const int tid = tid_, wid = __builtin_amdgcn_readfirstlane(tid >> 6), lane = tid & 63, wr = wid >> 2, wc = wid & 3, fr = lane & 15, fq = lane >> 4;
    const int K = g.K, nt = K / BK;
    unsigned voffA[2], voffB[2];
#pragma unroll
    for (int i = 0; i < 2; ++i) { int R, C; stage_rc(tid * 16 + i * 8192, R, C); const int Rb = Epi::PERM ? ((R & ~31) + perm32(R & 31)) : R;
        voffA[i] = (unsigned)(R * g.lda + C) * 2u; voffB[i] = (unsigned)(Rb * K + C) * 2u; }
    const size_t kstep = (size_t)(BK * 2);
    const size_t hstepB = (size_t)HALF * K * 2, hstepA = (size_t)HALF * g.lda * 2;
    const size_t tstepB = 2 * hstepB, tstepA = 2 * hstepA;
    const unsigned ldsw = (unsigned)wid * 1024u;
    const int aoff = lds_byte(wr * 64 + fr, fq * 8), boff = lds_byte(wc * 32 + fr, fq * 8);
#define PG8_SA(b, h) (((b) * 2 + (h)) * HTB)
#define PG8_SB(b, h) ((4 + (b) * 2 + (h)) * HTB)
#define PG8_STAGE(bufoff, gbase, voff) do { _Pragma("unroll") for (int _i = 0; _i < 2; ++_i) \
        __builtin_amdgcn_global_load_lds((const unsigned*)((const char*)(gbase) + (voff)[_i]), (PG8_LAS unsigned*)(lds + (bufoff) + ldsw + _i * 8192), 16, 0, 0); } while (0)
#define PG8_LDA(dst, b, h) do { _Pragma("unroll") for (int m = 0; m < 4; ++m) _Pragma("unroll") for (int k = 0; k < 2; ++k) dst[m][k] = *(const PG8_LAS bf16x8*)(lds + PG8_SA(b, h) + aoff + m * 2048 + k * 1024); } while (0)
#define PG8_LDB(dst, b, h) do { _Pragma("unroll") for (int n = 0; n < 2; ++n) _Pragma("unroll") for (int k = 0; k < 2; ++k) dst[n][k] = *(const PG8_LAS bf16x8*)(lds + PG8_SB(b, h) + boff + n * 2048 + k * 1024); } while (0)
#define PG8_MMA(ai, bj, At, Bt) do { __builtin_amdgcn_s_setprio(1); _Pragma("unroll") for (int m = 0; m < 4; ++m) _Pragma("unroll") for (int n = 0; n < 2; ++n) _Pragma("unroll") for (int k = 0; k < 2; ++k) \
        acc[ai][bj][m][n] = __builtin_amdgcn_mfma_f32_16x16x32_bf16(Bt[n][k], At[m][k], acc[ai][bj][m][n], 0, 0, 0); __builtin_amdgcn_s_setprio(0); } while (0)
#define PG8_WAIT_V(n) asm volatile("s_waitcnt vmcnt(" #n ")" ::: "memory")
#define PG8_WAIT_L(n) asm volatile("s_waitcnt lgkmcnt(" #n ")" ::: "memory")
#define PG8_BAR __builtin_amdgcn_s_barrier()
#define PG8_SCHED __builtin_amdgcn_sched_barrier(0)
    Unit cur, nxt; int ui = 0;
    if (!S.next(0, cur)) return;
    f32x4 acc[2][2][4][2];
#pragma unroll
    for (int a = 0; a < 2; ++a)
#pragma unroll
        for (int b = 0; b < 2; ++b)
#pragma unroll
            for (int m = 0; m < 4; ++m)
#pragma unroll
                for (int n = 0; n < 2; ++n) acc[a][b][m][n] = (f32x4){0.f, 0.f, 0.f, 0.f};
    bf16x8 At[4][2], B0[2][2], B1[2][2];
    const char* cA = (const char*)g.A + (size_t)cur.pm * tstepA; const char* cB = (const char*)g.Bt + (size_t)cur.pn * tstepB;
    S.a_ready(cur);
    if constexpr (SP2) {
        PG8_STAGE(PG8_SB(0, 0), cB, voffB); PG8_STAGE(PG8_SB(0, 1), cB + hstepB, voffB); PG8_STAGE(PG8_SA(0, 0), cA, voffA); PG8_STAGE(PG8_SA(0, 1), cA + hstepA, voffA);
        if (wr == 1) PG8_BAR;
        PG8_WAIT_V(2); PG8_BAR;
        PG8_STAGE(PG8_SB(1, 0), cB + kstep, voffB); PG8_STAGE(PG8_SA(1, 0), cA + kstep, voffA); PG8_STAGE(PG8_SB(1, 1), cB + hstepB + kstep, voffB);
        PG8_WAIT_V(6); PG8_BAR;
    } else {
        PG8_STAGE(PG8_SB(0, 0), cB, voffB); PG8_STAGE(PG8_SA(0, 0), cA, voffA); PG8_STAGE(PG8_SB(0, 1), cB + hstepB, voffB); PG8_STAGE(PG8_SA(0, 1), cA + hstepA, voffA);
        if (wr == 1) PG8_BAR;
        PG8_WAIT_V(4); PG8_BAR;
        PG8_STAGE(PG8_SB(1, 0), cB + kstep, voffB); PG8_STAGE(PG8_SA(1, 0), cA + kstep, voffA); PG8_STAGE(PG8_SB(1, 1), cB + hstepB + kstep, voffB);
        PG8_WAIT_V(6); PG8_BAR;
    }
    for (;;) {
        const bool has_next = S.next(ui + 1, nxt);
        const char* nA = has_next ? (const char*)g.A + (size_t)nxt.pm * tstepA : cA; const char* nB = has_next ? (const char*)g.Bt + (size_t)nxt.pn * tstepB : cB;
        for (int t = 0; t < nt; t += 2) {
            const bool last = (t == nt - 2);
            const char* a1 = cA + (size_t)(t + 1) * kstep;
            const char* a2 = last ? nA : cA + (size_t)(t + 2) * kstep; const char* b2 = last ? nB : cB + (size_t)(t + 2) * kstep;
            const char* a3 = a2 + kstep; const char* b3 = b2 + kstep;
            if (last && has_next) S.a_ready(nxt);
            if constexpr (SP2) {
            PG8_LDB(B0, 0, 0); PG8_LDB(B1, 0, 1); PG8_SCHED; PG8_LDA(At, 0, 0); PG8_STAGE(PG8_SA(1, 1), a1 + hstepA, voffA);
            PG8_WAIT_V(8); PG8_WAIT_L(0); PG8_BAR; PG8_MMA(0, 0, At, B0); PG8_MMA(0, 1, At, B1); PG8_BAR; PG8_SCHED;
            PG8_LDA(At, 0, 1); PG8_STAGE(PG8_SB(0, 0), b2, voffB); PG8_STAGE(PG8_SB(0, 1), b2 + hstepB, voffB); PG8_STAGE(PG8_SA(0, 0), a2, voffA);
            PG8_WAIT_V(8); PG8_WAIT_L(0); PG8_BAR; PG8_MMA(1, 0, At, B0); PG8_MMA(1, 1, At, B1); PG8_BAR; PG8_SCHED;
            PG8_LDB(B0, 1, 0); PG8_LDB(B1, 1, 1); PG8_SCHED; PG8_LDA(At, 1, 0); PG8_STAGE(PG8_SA(0, 1), a2 + hstepA, voffA);
            PG8_WAIT_V(8); PG8_WAIT_L(0); PG8_BAR; PG8_MMA(0, 0, At, B0); PG8_MMA(0, 1, At, B1); PG8_BAR; PG8_SCHED;
            PG8_LDA(At, 1, 1); PG8_STAGE(PG8_SB(1, 0), b3, voffB); PG8_STAGE(PG8_SB(1, 1), b3 + hstepB, voffB); PG8_STAGE(PG8_SA(1, 0), a3, voffA);
            PG8_WAIT_V(8); PG8_WAIT_L(0); PG8_BAR; PG8_MMA(1, 0, At, B0); PG8_MMA(1, 1, At, B1); PG8_BAR; PG8_SCHED;
            } else {
            PG8_LDB(B0, 0, 0); PG8_SCHED; PG8_LDA(At, 0, 0); PG8_STAGE(PG8_SA(1, 1), a1 + hstepA, voffA);
            PG8_WAIT_L(8); PG8_BAR; PG8_WAIT_L(0); PG8_MMA(0, 0, At, B0); PG8_BAR; PG8_SCHED;
            PG8_LDB(B1, 0, 1); PG8_STAGE(PG8_SB(0, 0), b2, voffB);
            PG8_BAR; PG8_WAIT_L(0); PG8_MMA(0, 1, At, B1); PG8_BAR;
            PG8_LDA(At, 0, 1); PG8_STAGE(PG8_SA(0, 0), a2, voffA);
            PG8_BAR; PG8_WAIT_L(0); PG8_MMA(1, 0, At, B0); PG8_BAR; PG8_SCHED;
            PG8_STAGE(PG8_SB(0, 1), b2 + hstepB, voffB);
            PG8_WAIT_V(6); PG8_BAR; PG8_MMA(1, 1, At, B1); PG8_BAR;
            PG8_LDB(B0, 1, 0); PG8_SCHED; PG8_LDA(At, 1, 0); PG8_STAGE(PG8_SA(0, 1), a2 + hstepA, voffA);
            PG8_WAIT_L(8); PG8_BAR; PG8_WAIT_L(0); PG8_MMA(0, 0, At, B0); PG8_BAR; PG8_SCHED;
            PG8_LDB(B1, 1, 1); PG8_STAGE(PG8_SB(1, 0), b3, voffB);
            PG8_BAR; PG8_WAIT_L(0); PG8_MMA(0, 1, At, B1); PG8_BAR;
            PG8_LDA(At, 1, 1); PG8_STAGE(PG8_SA(1, 0), a3, voffA);
            PG8_BAR; PG8_WAIT_L(0); PG8_MMA(1, 0, At, B0); PG8_BAR; PG8_SCHED;
            PG8_STAGE(PG8_SB(1, 1), b3 + hstepB, voffB);
            PG8_WAIT_V(6); PG8_BAR; PG8_MMA(1, 1, At, B1); PG8_BAR;
            }
        }
        if constexpr (ALIGN_EPI) { if (wr == 0) PG8_BAR; }
        if constexpr (!Epi::AFTER_DRAIN) { int fr_ = fr, fq_ = fq; asm volatile("" : "+v"(fr_), "+v"(fq_));
            E(acc, cur, wr, wc, fr_, fq_); S.done(cur); }
        if (!has_next) break;
#pragma unroll
        for (int a = 0; a < 2; ++a)
#pragma unroll
            for (int b = 0; b < 2; ++b)
#pragma unroll
                for (int m = 0; m < 4; ++m)
#pragma unroll
                    for (int n = 0; n < 2; ++n) acc[a][b][m][n] = (f32x4){0.f, 0.f, 0.f, 0.f};
        cur = nxt; cA = nA; cB = nB; ++ui;
        if constexpr (ALIGN_EPI) { if (wr == 1) PG8_BAR; }
    }
    PG8_WAIT_V(0);
    if constexpr (!ALIGN_EPI) { if (wr == 0) PG8_BAR; }
    PG8_BAR;
    if constexpr (Epi::AFTER_DRAIN) { E.fused(acc, cur, wr, wc, fr, fq, lds, wid, lane); S.done(cur); }
#undef PG8_SA
#undef PG8_SB
#undef PG8_STAGE
#undef PG8_LDA
#undef PG8_LDB
#undef PG8_MMA
#undef PG8_WAIT_V
#undef PG8_WAIT_L
#undef PG8_BAR
#undef PG8_SCHED
}
}

constexpr int BATCH = 2, SEQ = 8192, DM = 1024, T = BATCH * SEQ;
constexpr int PLE = 256, NH = 4, NOPE = 128, ROPE = 64, VD = 128, QKD = 192, QLORA = 256, KVLORA = 128, AW = 512, CW = 512;
constexpr int INTOT = 3008, INPAD = 3072;
constexpr int PP = 2048;
constexpr int C_CQ = 0, C_CKV = 256, C_KPE = 384, C_ZA = 512, C_G = 1024, C_PR = 1536;
constexpr int UPK = 384, UPN = 1792;
constexpr float EPS = 1e-6f;
constexpr int NWAVES = 8, NTHREADS = 512;

constexpr size_t MiB = 1u << 20;
constexpr size_t WS_WIN = 0;
constexpr size_t WS_WUP = 6 * MiB;
constexpr size_t WS_WO = 8 * MiB;
constexpr size_t WS_WPLG = 10 * MiB;
constexpr size_t WS_WPL = 12 * MiB;
constexpr size_t WS_XN = 16 * MiB;
constexpr size_t WS_PB = 48 * MiB;
constexpr size_t WS_PROJ = 56 * MiB;
constexpr size_t WS_QKVRAW = 152 * MiB;
constexpr size_t WS_K = 208 * MiB;
constexpr size_t WS_VT = 232 * MiB;
constexpr size_t WS_END = 248 * MiB;
constexpr size_t WS_ROWSQ = 14 * MiB;
constexpr size_t WS_X1B = WS_PROJ;
constexpr size_t WS_PL = WS_PROJ + 64 * MiB;

#define LAS __attribute__((address_space(3)))
typedef unsigned short bf16_t;
typedef short bf16x8 __attribute__((ext_vector_type(8)));
typedef float f32x4 __attribute__((ext_vector_type(4)));
typedef float f32x16 __attribute__((ext_vector_type(16)));
typedef unsigned u32x4 __attribute__((ext_vector_type(4)));
typedef unsigned u32x2 __attribute__((ext_vector_type(2)));

struct Args {
    const float* x; const float* p; const int* pos; const float* g_in; const float* w_in; const float* g_cq; const float* w_uq; const float* g_ckv; const float* w_ukv;
    const float* g_q; const float* g_k; const float* conv_w; const float* g_oa; const float* g_oc; const float* w_o; const float* w_pl; const float* w_plg; const float* g_pl;
    float* out; unsigned char* ws; int never; int pad;
};

__device__ __forceinline__ float wave_sum(float v) {
#pragma unroll
    for (int o = 1; o < 64; o <<= 1) v += __shfl_xor(v, o);
    return v;
}
__device__ __forceinline__ float max_xor32(float x) { const u32x2 r = __builtin_amdgcn_permlane32_swap(__float_as_uint(x), __float_as_uint(x), false, false); return fmaxf(__uint_as_float(r.x), __uint_as_float(r.y)); }
__device__ __forceinline__ float silu_f(float z) { return z / (1.f + __expf(-z)); }

__device__ __forceinline__ int win_row(int n) {
    if (n < 448) return n;
    if (n < 960) return n + 64;
    const int t = n - 960, q = t >> 9, ch = t & 511, qn = (q == 0) ? 0 : (q == 1) ? 2 : (q == 2) ? 3 : 1, cg = ch >> 6, ci = ch & 63;
    return 1024 + 256 * cg + 128 * (qn >> 1) + 32 * (ci >> 4) + 16 * (qn & 1) + (ci & 15);
}
template <bool WINMAP = false>
__device__ __forceinline__ void p0_transpose_item(const float* W, int N, bf16_t* WT, int ldt, int row_off, int col_off, LAS float* scr, int item, int lane, const float* gk = nullptr) {
    const int nblk = N / 32, kb = item / nblk, nb = item % nblk, k0 = 64 * kb, n0 = 32 * nb;
    { f32x4 v[8];
#pragma unroll
      for (int i = 0; i < 8; ++i) v[i] = *(const f32x4*)(W + (size_t)(k0 + 8 * i + (lane >> 3)) * N + n0 + 4 * (lane & 7));
#pragma unroll
      for (int i = 0; i < 8; ++i) { const int kk = 8 * i + (lane >> 3); const float gg = gk ? gk[k0 + kk] : 1.f; LAS float* d = scr + kk * 33 + 4 * (lane & 7);
          d[0] = v[i][0] * gg; d[1] = v[i][1] * gg; d[2] = v[i][2] * gg; d[3] = v[i][3] * gg; } }
    asm volatile("s_waitcnt lgkmcnt(0)" ::: "memory");
    const int c = lane & 7;
#pragma unroll
    for (int j = 0; j < 4; ++j) { const int n = (lane >> 3) + 8 * j; const LAS float* s = scr + (8 * c) * 33 + n;
        u32x4 o; o.x = pk2(s[0 * 33], s[1 * 33]); o.y = pk2(s[2 * 33], s[3 * 33]); o.z = pk2(s[4 * 33], s[5 * 33]); o.w = pk2(s[6 * 33], s[7 * 33]);
        *(u32x4*)(WT + (size_t)(WINMAP ? win_row(n0 + n) : row_off + n0 + n) * ldt + col_off + k0 + 8 * c) = o; }
    asm volatile("s_waitcnt lgkmcnt(0)" ::: "memory");
}

__device__ __forceinline__ void phase0(const Args& a, LAS unsigned char* lds, int gw_, int NGW, int wave, int lane_) {
    int lane = lane_; asm volatile("" : "+v"(lane));
    const int gw = blockIdx.x * NWAVES + wave;
    unsigned char* ws = a.ws;
    bf16_t* WinT = (bf16_t*)(ws + WS_WIN); bf16_t* WupT = (bf16_t*)(ws + WS_WUP); bf16_t* WoT = (bf16_t*)(ws + WS_WO); bf16_t* WplgT = (bf16_t*)(ws + WS_WPLG); bf16_t* WplT = (bf16_t*)(ws + WS_WPL);
    LAS float* scr = (LAS float*)(lds + wave * 16384);
    constexpr int I_IN = (DM / 64) * (INTOT / 32), I_UQ = (QLORA / 64) * (768 / 32), I_UKV = (KVLORA / 64) * (1024 / 32), I_O = (DM / 64) * (DM / 32), I_PLG = I_O, I_PL = (PLE / 64) * (DM / 32);
    constexpr int NITEMS = I_IN + I_UQ + I_UKV + I_PL;
    (void)I_O; (void)I_PLG; (void)WoT; (void)WplgT;
    for (int it = gw; it < NITEMS; it += NGW) {
        int r = it;
        if (r < I_IN) { p0_transpose_item<true>(a.w_in, INTOT, WinT, DM, 0, 0, scr, r, lane); continue; } r -= I_IN;
        if (r < I_UQ) { p0_transpose_item(a.w_uq, 768, WupT, UPK, 0, 0, scr, r, lane, a.g_cq); continue; } r -= I_UQ;
        if (r < I_UKV) { p0_transpose_item(a.w_ukv, 1024, WupT, UPK, 768, 256, scr, r, lane, a.g_ckv); continue; } r -= I_UKV;
        p0_transpose_item(a.w_pl, DM, WplT, PLE, 0, 0, scr, r, lane);
    }
    const int gt = gw * 64 + lane, NGT = NGW * 64;
    for (int c = gt; c < (INPAD - INTOT) * DM / 8; c += NGT) *(u32x4*)(WinT + (size_t)448 * DM + (size_t)c * 8) = (u32x4){0u, 0u, 0u, 0u};
    for (int c = gt; c < UPN * (UPK / 8); c += NGT) { const int row = c / (UPK / 8), col = (c % (UPK / 8)) * 8; const bool diag = (row < 768) ? (col < 256) : (col >= 256);
        if (!diag) *(u32x4*)(WupT + (size_t)row * UPK + col) = (u32x4){0u, 0u, 0u, 0u}; }
    { float* rowsq = (float*)(ws + WS_ROWSQ); for (int c = gt; c < T; c += NGT) rowsq[c] = 0.f; }
    { bf16_t* PB = (bf16_t*)(ws + WS_PB);
      for (int c = gt; c < T * PLE / 8; c += NGT) { const f32x4 v0 = *(const f32x4*)(a.p + (size_t)c * 8), v1 = *(const f32x4*)(a.p + (size_t)c * 8 + 4);
          u32x4 o; o.x = pk2(v0[0], v0[1]); o.y = pk2(v0[2], v0[3]); o.z = pk2(v1[0], v1[1]); o.w = pk2(v1[2], v1[3]); *(u32x4*)(PB + (size_t)c * 8) = o; } }
    { bf16_t* XN = (bf16_t*)(ws + WS_XN);
      f32x4 g[4];
#pragma unroll
      for (int j = 0; j < 4; ++j) g[j] = *(const f32x4*)(a.g_in + 4 * lane + 256 * j);
      for (int m = gw; m < T; m += NGW) { const float* xr = a.x + (size_t)m * DM + 4 * lane; f32x4 v[4]; float s = 0.f;
#pragma unroll
          for (int j = 0; j < 4; ++j) { v[j] = *(const f32x4*)(xr + 256 * j); s += (v[j][0] * v[j][0] + v[j][1] * v[j][1]) + (v[j][2] * v[j][2] + v[j][3] * v[j][3]); }
          const float rstd = rsqrtf(wave_sum(s) * (1.f / DM) + EPS);
#pragma unroll
          for (int j = 0; j < 4; ++j) { const f32x4 o = v[j] * rstd * g[j]; u32x2 w; w.x = pk2(o[0], o[1]); w.y = pk2(o[2], o[3]); *(u32x2*)(XN + (size_t)m * DM + 4 * lane + 256 * j) = w; } } }
}

__device__ __forceinline__ void late_transposes(const Args& a, LAS unsigned char* lds, int rank_wave, int n_waves, int wave, int lane_) {
    int lane = lane_; asm volatile("" : "+v"(lane));
    bf16_t* WoT = (bf16_t*)(a.ws + WS_WO); bf16_t* WplgT = (bf16_t*)(a.ws + WS_WPLG);
    LAS float* scr = (LAS float*)(lds + wave * 16384);
    constexpr int I_O = (DM / 64) * (DM / 32);
    for (int it = rank_wave; it < 2 * I_O; it += n_waves) {
        if (it < I_O) p0_transpose_item(a.w_o, DM, WoT, DM, 0, 0, scr, it, lane);
        else p0_transpose_item(a.w_plg, DM, WplgT, DM, 0, 0, scr, it - I_O, lane, a.g_pl);
    }
}
struct TokIn { unsigned short q[4][3]; unsigned short k[4][2]; unsigned short kpe; u32x2 cq; unsigned ckv; int pos; };
__device__ __forceinline__ void p4_load(TokIn& t, const bf16_t* PROJ, const bf16_t* RAW, const int* pos, int m, int lane) {
    const bf16_t* pr = PROJ + (size_t)m * PP; const bf16_t* rr = RAW + (size_t)m * UPN;
#pragma unroll
    for (int h = 0; h < NH; ++h) {
#pragma unroll
        for (int i = 0; i < 3; ++i) t.q[h][i] = rr[h * QKD + lane + 64 * i];
#pragma unroll
        for (int i = 0; i < 2; ++i) t.k[h][i] = rr[768 + h * 256 + lane + 64 * i];
    }
    t.kpe = pr[C_KPE + lane]; t.cq = *(const u32x2*)(pr + C_CQ + 4 * lane); t.ckv = *(const unsigned*)(pr + C_CKV + 2 * lane); t.pos = pos[m];
}
__device__ __forceinline__ unsigned short bf16r(float v) { return (unsigned short)(pk2(v, 0.f) & 0xffffu); }
__device__ __forceinline__ void phase4a(const Args& a, int gw, int NGW, int lane_) {
    int lane = lane_; asm volatile("" : "+v"(lane));
    const bf16_t* PROJ = (const bf16_t*)(a.ws + WS_PROJ); const bf16_t* RAW = (const bf16_t*)(a.ws + WS_QKVRAW);
    bf16_t* Q = (bf16_t*)(a.ws + WS_XN); bf16_t* K = (bf16_t*)(a.ws + WS_K);
    const float gq0 = a.g_q[lane], gq1 = a.g_q[lane + 64], gq2 = a.g_q[lane + 128];
    const float gk0 = a.g_k[lane], gk1 = a.g_k[lane + 64], gk2 = a.g_k[lane + 128];
    const int fi = lane & 31; const float inv_freq = 1.0f / powf(10000.0f, (float)(2 * fi) / 64.0f);
    const float qscale = 0.07216878364870322f * 1.4426950408889634f;
    const float sgn = (lane < 32) ? -1.f : 1.f;
    TokIn cur, nxt; int m = gw;
    if (m < T) p4_load(cur, PROJ, RAW, a.pos, m, lane);
    for (; m < T; m += NGW) {
        const int mn = m + NGW; if (mn < T) p4_load(nxt, PROJ, RAW, a.pos, mn, lane);
        const int b = m / SEQ, s = m % SEQ;
        float qv[4][3], kv[4][2]; const float kpe = bf1(cur.kpe);
        float red[11];
        { const float c0 = bflo(cur.cq.x), c1 = bfhi(cur.cq.x), c2 = bflo(cur.cq.y), c3 = bfhi(cur.cq.y), d0 = bflo(cur.ckv), d1 = bfhi(cur.ckv);
          red[0] = (c0 * c0 + c1 * c1) + (c2 * c2 + c3 * c3); red[1] = d0 * d0 + d1 * d1; red[2] = kpe * kpe; }
#pragma unroll
        for (int h = 0; h < NH; ++h) { qv[h][0] = bf1(cur.q[h][0]); qv[h][1] = bf1(cur.q[h][1]); qv[h][2] = bf1(cur.q[h][2]); kv[h][0] = bf1(cur.k[h][0]); kv[h][1] = bf1(cur.k[h][1]);
            red[3 + h] = qv[h][0] * qv[h][0] + qv[h][1] * qv[h][1] + qv[h][2] * qv[h][2]; red[7 + h] = kv[h][0] * kv[h][0] + kv[h][1] * kv[h][1]; }
#pragma unroll
        for (int o = 1; o < 64; o <<= 1) {
#pragma unroll
            for (int e = 0; e < 11; ++e) red[e] += __shfl_xor(red[e], o);
        }
        const float rq = rsqrtf(red[0] * (1.f / QLORA) + EPS), rkv = rsqrtf(red[1] * (1.f / KVLORA) + EPS);
        const float ang = (float)cur.pos * inv_freq; float sn, cs; sincosf(ang, &sn, &cs);
        const float kp = kpe * gk2; const float kpo = __shfl_xor(kp, 32); const float kprope = kp * cs + sgn * kpo * sn;
#pragma unroll
        for (int h = 0; h < NH; ++h) {
            const float rs = rsqrtf(rq * rq * red[3 + h] * (1.f / QKD) + EPS) * rq * qscale;
            const float v0 = qv[h][0] * rs * gq0, v1 = qv[h][1] * rs * gq1, v2 = qv[h][2] * rs * gq2;
            const float o2 = __shfl_xor(v2, 32); const float r2 = v2 * cs + sgn * o2 * sn;
            bf16_t* qo = Q + ((size_t)(b * NH + h) * SEQ + s) * QKD;
            qo[lane] = bf16r(v0); qo[lane + 64] = bf16r(v1); qo[lane + 128] = bf16r(r2);
            const float rk = rsqrtf((rkv * rkv * red[7 + h] + red[2]) * (1.f / QKD) + EPS);
            bf16_t* ko = K + ((size_t)(b * NH + h) * SEQ + s) * QKD;
            ko[lane] = bf16r(kv[h][0] * rkv * rk * gk0); ko[lane + 64] = bf16r(kv[h][1] * rkv * rk * gk1); ko[lane + 128] = bf16r(kprope * rk);
        }
        cur = nxt;
    }
}
__device__ __forceinline__ void phase4b(const Args& a, LAS unsigned char* lds, int tid_) {
    int tid = tid_; asm volatile("" : "+v"(tid));
    const bf16_t* PROJ = (const bf16_t*)(a.ws + WS_PROJ); const bf16_t* RAW = (const bf16_t*)(a.ws + WS_QKVRAW); bf16_t* VT = (bf16_t*)(a.ws + WS_VT);
    constexpr int PITCH = 1040;
    LAS float* rkl = (LAS float*)(lds + 64 * PITCH);
    const int lane = tid & 63, wave = tid >> 6;
    for (int tile = blockIdx.x; tile < T / 64; tile += gridDim.x) {
        const int row0 = tile * 64;
        { float red[8];
#pragma unroll
          for (int e = 0; e < 8; ++e) { const unsigned c = *(const unsigned*)(PROJ + (size_t)(row0 + wave * 8 + e) * PP + C_CKV + 2 * lane); const float d0 = bflo(c), d1 = bfhi(c); red[e] = d0 * d0 + d1 * d1; }
#pragma unroll
          for (int o = 1; o < 64; o <<= 1) {
#pragma unroll
              for (int e = 0; e < 8; ++e) red[e] += __shfl_xor(red[e], o);
          }
#pragma unroll
          for (int e = 0; e < 8; ++e) if (lane == e) rkl[wave * 8 + e] = rsqrtf(red[e] * (1.f / KVLORA) + EPS); }
#pragma unroll
        for (int i = 0; i < 8; ++i) { const int c = tid + 512 * i, tok = c >> 6, rem = c & 63, h = rem >> 4, part = rem & 15;
            const u32x4 v = *(const u32x4*)(RAW + (size_t)(row0 + tok) * UPN + 768 + h * 256 + 128 + part * 8);
            *(LAS u32x4*)(lds + tok * PITCH + (h * 128 + part * 8) * 2) = v; }
        __syncthreads();
        const int b = row0 / SEQ, s0 = row0 % SEQ, ch = tid & 7;
        int key[8];
#pragma unroll
        for (int e = 0; e < 8; ++e) { const int p = ch * 8 + e, q = p & 15; key[e] = 16 * (p >> 4) + 8 * ((q & 7) >> 2) + 4 * (q >> 3) + (q & 3); }
        float rk[8];
#pragma unroll
        for (int e = 0; e < 8; ++e) rk[e] = rkl[key[e]];
#pragma unroll
        for (int i = 0; i < 8; ++i) {
            const int row = (tid >> 3) + 64 * i, h = row >> 7, d = row & 127;
            unsigned w[4];
#pragma unroll
            for (int e = 0; e < 4; ++e) {
                const float lo = bf1(*(const LAS unsigned short*)(lds + key[2 * e] * PITCH + row * 2)) * rk[2 * e], hi = bf1(*(const LAS unsigned short*)(lds + key[2 * e + 1] * PITCH + row * 2)) * rk[2 * e + 1];
                w[e] = pk2(lo, hi);
            }
            *(u32x4*)(VT + ((size_t)(b * NH + h) * VD + d) * SEQ + s0 + ch * 8) = (u32x4){w[0], w[1], w[2], w[3]};
        }
        __syncthreads();
    }
}

#define MFMA32(a, b, c) __builtin_amdgcn_mfma_f32_32x32x16_bf16((a), (b), (c), 0, 0, 0)
constexpr int KTILE = 64 * QKD * 2  , VTILE = VD * 64 * 2  , KRING = 0, VRING = 3 * KTILE;
#define ATT_DMA(gptr, ldsoff) __builtin_amdgcn_global_load_lds((const unsigned*)(gptr), (LAS unsigned*)(lds + (ldsoff)), 16, 0, 0)
#define ATT_ISSUE_K(jt, stage) do { _Pragma("unroll") for (int i_ = 0; i_ < 3; ++i_) ATT_DMA(kg + (size_t)(jt) * KTILE + kgo[i_], KRING + (stage) * KTILE + (wave * 3 + i_) * 1024); } while (0)
#define ATT_ISSUE_V(jt, stage) do { _Pragma("unroll") for (int i_ = 0; i_ < 2; ++i_) ATT_DMA(vg + (size_t)(jt) * 128 + vgo[i_], VRING + (stage) * VTILE + (wave * 2 + i_) * 1024); } while (0)

__device__ __forceinline__ void attn_unit(LAS unsigned char* lds, const bf16_t* Qg, const bf16_t* Kg, const bf16_t* Vtg, bf16_t* Og, int bh, int qb, int tid_, int wave, int lane_) {
    int tid = tid_; asm volatile("" : "+v"(tid));
    const int lane = tid & 63;
    const int rg = wave & 3, kh = wave >> 2, r = lane & 31, hi = lane >> 5;
    const int b = bh >> 2, h = bh & 3;
    const int nt = 2 * (qb + 1);
    const float NEG = -1e30f;
    bf16x8 qf[12];
    { const bf16_t* qp = Qg + ((size_t)bh * SEQ + 128 * qb + 32 * rg + r) * QKD + 8 * hi;
#pragma unroll
      for (int kk = 0; kk < 12; ++kk) qf[kk] = *(const bf16x8*)(qp + 16 * kk); }
    const unsigned char* kg = (const unsigned char*)(Kg + (size_t)bh * SEQ * QKD);
    const unsigned char* vg = (const unsigned char*)(Vtg + (size_t)bh * VD * SEQ);
    unsigned kgo[3], vgo[2];
#pragma unroll
    for (int i = 0; i < 3; ++i) { const int a = (wave * 3 + i) * 1024 + lane * 16, row = a / 384, cp = (a % 384) >> 4, cl = (cp & ~7) | ((cp ^ (row >> 1)) & 7); kgo[i] = (unsigned)(row * 384 + cl * 16); }
#pragma unroll
    for (int i = 0; i < 2; ++i) { const int a = (wave * 2 + i) * 1024 + lane * 16, row = a >> 7, cp = (a & 127) >> 4, cl = (cp ^ (row >> 1)) & 7; vgo[i] = (unsigned)(row * (SEQ * 2) + cl * 16); }
    const int sw = (r >> 1) & 7;
    unsigned kro[4], vro[2];
#pragma unroll
    for (int q = 0; q < 4; ++q) kro[q] = (unsigned)((32 * kh + r) * 384 + (((2 * q + hi) ^ sw) * 16));
#pragma unroll
    for (int s = 0; s < 2; ++s) vro[s] = (unsigned)(VRING + r * 128 + (((4 * kh + 2 * s + hi) ^ sw) * 16));
    f32x16 o[4]; float mrun = NEG, lrun = 0.f;
#pragma unroll
    for (int dt = 0; dt < 4; ++dt)
#pragma unroll
        for (int i = 0; i < 16; ++i) o[dt][i] = 0.f;
    ATT_ISSUE_K(0, 0); ATT_ISSUE_V(0, 0); ATT_ISSUE_K(1, 1);
    ATT_ISSUE_K((2 < nt) ? 2 : nt - 1, 2); ATT_ISSUE_V(1, 1);
    asm volatile("s_waitcnt vmcnt(5)" ::: "memory"); __builtin_amdgcn_s_barrier(); asm volatile("" ::: "memory");
    f32x16 sc, sn;
    {
#pragma unroll
      for (int i = 0; i < 16; ++i) sc[i] = 0.f;
#pragma unroll
      for (int kk = 0; kk < 12; ++kk) { const bf16x8 kf = *(const LAS bf16x8*)(lds + KRING + kro[kk & 3] + (kk >> 2) * 128); sc = MFMA32(kf, qf[kk], sc); if ((kk & 3) == 3) __builtin_amdgcn_sched_barrier(0); } }
    asm volatile("s_waitcnt lgkmcnt(0)" ::: "memory"); __builtin_amdgcn_s_barrier(); asm volatile("" ::: "memory");
    const float NINF = -__builtin_inff();
    int s0 = 0, s1 = 1, s2 = 2;
    for (int j = 0; j < nt; ++j) {
        const int relc = 64 * (j - 2 * qb) + 32 * kh - 32 * rg;
        const int j3 = (j + 3 < nt) ? j + 3 : nt - 1, j2 = (j + 2 < nt) ? j + 2 : nt - 1;
        const LAS unsigned char* kb = lds + KRING + s1 * KTILE;
        const LAS unsigned char* vb = lds + s0 * VTILE;
        if (relc >= 0) {
            const int thr = (relc == 0) ? r : -1;
#pragma unroll
            for (int i = 0; i < 16; ++i) { const int key = (i & 3) + 8 * (i >> 2) + 4 * hi; if (key > thr) sc[i] = NINF; }
        }
#define ATT_KRD(dst, g) do { _Pragma("unroll") for (int q_ = 0; q_ < 4; ++q_) dst[q_] = *(const LAS bf16x8*)(kb + kro[q_] + (g) * 128); } while (0)
        bf16x8 fa[4], fb[4];
        ATT_KRD(fa, 0); ATT_KRD(fb, 1);
#pragma unroll
        for (int i = 0; i < 16; ++i) sn[i] = 0.f;
        float mx = sc[0];
#pragma unroll
        for (int i = 1; i < 16; ++i) mx = fmaxf(mx, sc[i]);
        mx = max_xor32(mx);
        __builtin_amdgcn_sched_barrier(0);
#pragma unroll
        for (int q = 0; q < 4; ++q) sn = MFMA32(fa[q], qf[q], sn);
        ATT_KRD(fa, 2);
        __builtin_amdgcn_sched_barrier(0);
        if (__builtin_amdgcn_ballot_w64(mx > mrun + 8.f) != 0ull) {
            const float mnew = fmaxf(mrun, mx); const float alpha = __builtin_amdgcn_exp2f(mrun - mnew); mrun = mnew; lrun *= alpha;
#pragma unroll
            for (int dt = 0; dt < 4; ++dt) o[dt] = o[dt] * alpha;
        }
        float ps = 0.f; u32x4 p0, p1;
#pragma unroll
        for (int q = 0; q < 4; ++q) sn = MFMA32(fb[q], qf[4 + q], sn);
#pragma unroll
        for (int i = 0; i < 8; ++i) { sc[i] = __builtin_amdgcn_exp2f(sc[i] - mrun); ps += sc[i]; }
        p0.x = pk2(sc[0], sc[1]); p0.y = pk2(sc[2], sc[3]); p0.z = pk2(sc[4], sc[5]); p0.w = pk2(sc[6], sc[7]);
        __builtin_amdgcn_sched_barrier(0);
        ATT_ISSUE_K(j3, s0);
        __builtin_amdgcn_sched_barrier(0);
        fb[0] = *(const LAS bf16x8*)(vb + vro[0]); fb[1] = *(const LAS bf16x8*)(vb + vro[1]); fb[2] = *(const LAS bf16x8*)(vb + vro[0] + 4096); fb[3] = *(const LAS bf16x8*)(vb + vro[1] + 4096);
#pragma unroll
        for (int q = 0; q < 4; ++q) sn = MFMA32(fa[q], qf[8 + q], sn);
#pragma unroll
        for (int i = 8; i < 16; ++i) { sc[i] = __builtin_amdgcn_exp2f(sc[i] - mrun); ps += sc[i]; }
        p1.x = pk2(sc[8], sc[9]); p1.y = pk2(sc[10], sc[11]); p1.z = pk2(sc[12], sc[13]); p1.w = pk2(sc[14], sc[15]);
        lrun += ps;
        __builtin_amdgcn_sched_barrier(0);
        ATT_ISSUE_V(j2, s2);
        __builtin_amdgcn_sched_barrier(0);
        fa[0] = *(const LAS bf16x8*)(vb + vro[0] + 8192); fa[1] = *(const LAS bf16x8*)(vb + vro[1] + 8192); fa[2] = *(const LAS bf16x8*)(vb + vro[0] + 12288); fa[3] = *(const LAS bf16x8*)(vb + vro[1] + 12288);
        { const bf16x8 pf0 = __builtin_bit_cast(bf16x8, p0), pf1 = __builtin_bit_cast(bf16x8, p1);
          o[0] = MFMA32(fb[0], pf0, o[0]); o[0] = MFMA32(fb[1], pf1, o[0]); o[1] = MFMA32(fb[2], pf0, o[1]); o[1] = MFMA32(fb[3], pf1, o[1]);
          __builtin_amdgcn_sched_barrier(0);
          o[2] = MFMA32(fa[0], pf0, o[2]); o[2] = MFMA32(fa[1], pf1, o[2]); o[3] = MFMA32(fa[2], pf0, o[3]); o[3] = MFMA32(fa[3], pf1, o[3]); }
        asm volatile("s_waitcnt vmcnt(5) lgkmcnt(0)" ::: "memory"); __builtin_amdgcn_s_barrier(); asm volatile("" ::: "memory");
        sc = sn;
        { const int t = s0; s0 = s1; s1 = s2; s2 = t; }
    }
    asm volatile("s_waitcnt vmcnt(0) lgkmcnt(0)" ::: "memory"); __builtin_amdgcn_s_barrier(); asm volatile("" ::: "memory");
    LAS float* cs = (LAS float*)(lds + rg * (66 * 64 * 4)) + lane;
    if (kh == 1) {
#pragma unroll
        for (int dt = 0; dt < 4; ++dt)
#pragma unroll
            for (int i = 0; i < 16; ++i) cs[(dt * 16 + i) * 64] = o[dt][i];
        cs[64 * 64] = mrun; cs[65 * 64] = lrun;
    }
    __syncthreads();
    if (kh == 0) {
        const float m1 = cs[64 * 64], l1 = cs[65 * 64];
        const float mf = fmaxf(mrun, m1), a0 = __builtin_amdgcn_exp2f(mrun - mf), a1 = __builtin_amdgcn_exp2f(m1 - mf);
        float lt = lrun * a0 + l1 * a1; lt += __shfl_xor(lt, 32);
        const float inv = 1.f / lt;
        bf16_t* op = Og + ((size_t)b * SEQ + 128 * qb + 32 * rg + r) * AW + h * VD + 4 * hi;
#pragma unroll
        for (int dt = 0; dt < 4; ++dt)
#pragma unroll
            for (int g = 0; g < 4; ++g) {
                float v[4];
#pragma unroll
                for (int e = 0; e < 4; ++e) v[e] = (o[dt][4 * g + e] * a0 + cs[(dt * 16 + 4 * g + e) * 64] * a1) * inv;
                u32x2 w; w.x = pk2(v[0], v[1]); w.y = pk2(v[2], v[3]);
                *(u32x2*)(op + 32 * dt + 8 * g) = w;
            }
    }
    __syncthreads();
}

__device__ __forceinline__ void unpack8(const u32x4 v, float (&f)[8]) { f[0] = bflo(v.x); f[1] = bfhi(v.x); f[2] = bflo(v.y); f[3] = bfhi(v.y); f[4] = bflo(v.z); f[5] = bfhi(v.z); f[6] = bflo(v.w); f[7] = bfhi(v.w); }
struct Tok6 { u32x4 o, za, g, pr; };
__device__ __forceinline__ void p6_load(Tok6& t, const bf16_t* PROJ, const bf16_t* O, int m, int c0) {
    const bf16_t* pr = PROJ + (size_t)m * PP;
    t.o = *(const u32x4*)(O + (size_t)m * AW + c0); t.za = *(const u32x4*)(pr + C_ZA + c0); t.g = *(const u32x4*)(pr + C_G + c0); t.pr = *(const u32x4*)(pr + C_PR + c0);
}
__device__ __forceinline__ void phase6(const Args& a, int gw, int NGW, int lane_) {
    int lane = lane_; asm volatile("" : "+v"(lane));
    const bf16_t* PROJ = (const bf16_t*)(a.ws + WS_PROJ); const bf16_t* O = (const bf16_t*)(a.ws + WS_QKVRAW); bf16_t* Y = (bf16_t*)(a.ws + WS_XN);
    const int c0 = 8 * lane;
    float goa[8], goc[8], w0[8], w1[8], w2[8];
#pragma unroll
    for (int e = 0; e < 8; ++e) { goa[e] = a.g_oa[c0 + e]; goc[e] = a.g_oc[c0 + e]; w0[e] = a.conv_w[c0 + e]; w1[e] = a.conv_w[CW + c0 + e]; w2[e] = a.conv_w[2 * CW + c0 + e]; }
    for (int ch = gw; ch < T / 8; ch += NGW) {
        const int m0 = ch * 8, s0 = m0 % SEQ;
        float pm2[8], pm1[8];
        if (s0 >= 2) { unpack8(*(const u32x4*)(PROJ + (size_t)(m0 - 1) * PP + C_PR + c0), pm1); unpack8(*(const u32x4*)(PROJ + (size_t)(m0 - 2) * PP + C_PR + c0), pm2); }
        else {
#pragma unroll
            for (int e = 0; e < 8; ++e) { pm1[e] = 0.f; pm2[e] = 0.f; }
        }
        Tok6 cur, nxt; p6_load(cur, PROJ, O, m0, c0);
#pragma unroll 1
        for (int i = 0; i < 8; ++i) {
            const int m = m0 + i;
            if (i < 7) p6_load(nxt, PROJ, O, m + 1, c0);
            float ov[8], za[8], gg[8], p0[8], v[8], u[8];
            unpack8(cur.o, ov); unpack8(cur.za, za); unpack8(cur.g, gg); unpack8(cur.pr, p0);
            float ss = 0.f, s2 = 0.f;
#pragma unroll
            for (int e = 0; e < 8; ++e) { v[e] = ov[e] * silu_f(za[e]); ss += v[e] * v[e];
                u[e] = gg[e] * (w2[e] * p0[e] + w1[e] * pm1[e] + w0[e] * pm2[e]); s2 += u[e] * u[e]; pm2[e] = pm1[e]; pm1[e] = p0[e]; }
#pragma unroll
            for (int o = 1; o < 64; o <<= 1) { ss += __shfl_xor(ss, o); s2 += __shfl_xor(s2, o); }
            const float rs = rsqrtf(ss * (1.f / AW) + EPS), rc = rsqrtf(s2 * (1.f / CW) + EPS);
            u32x4 w; w.x = pk2(v[0] * rs * goa[0], v[1] * rs * goa[1]); w.y = pk2(v[2] * rs * goa[2], v[3] * rs * goa[3]); w.z = pk2(v[4] * rs * goa[4], v[5] * rs * goa[5]); w.w = pk2(v[6] * rs * goa[6], v[7] * rs * goa[7]);
            *(u32x4*)(Y + (size_t)m * DM + c0) = w;
            w.x = pk2(u[0] * rc * goc[0], u[1] * rc * goc[1]); w.y = pk2(u[2] * rc * goc[2], u[3] * rc * goc[3]); w.z = pk2(u[4] * rc * goc[4], u[5] * rc * goc[5]); w.w = pk2(u[6] * rc * goc[6], u[7] * rc * goc[7]);
            *(u32x4*)(Y + (size_t)m * DM + AW + c0) = w;
            cur = nxt;
        }
    }
}

#define XB_TMO      128
#define XB_XCNT(j)  (256  + 64 * (j))
#define XB_XSUB(j)  (1280 + 64 * (j))
#define XB_XGEN(j)  (2304 + 64 * (j))
#define XB_TOP      3328
#define XB_TOPGEN   3392
#define XCD_BAR_WORDS 3456
#define XB_SPIN_CAP (1u << 18)

__device__ __forceinline__ unsigned xb_ld(unsigned* p)              { return __hip_atomic_load(p, __ATOMIC_RELAXED, __HIP_MEMORY_SCOPE_AGENT); }
__device__ __forceinline__ unsigned xb_add(unsigned* p, unsigned v) { return __hip_atomic_fetch_add(p, v, __ATOMIC_RELAXED, __HIP_MEMORY_SCOPE_AGENT); }
__device__ __forceinline__ unsigned xb_xcc_id() { return (unsigned)__builtin_amdgcn_s_getreg((3 << 11) | 20) & 0xFu; }
#define XB_SPIN(cond, bar) do { unsigned _sp = 0; while (cond) { __builtin_amdgcn_s_sleep(1); \
    if ((++_sp & 255u) == 0u) { if (xb_ld(&(bar)[XB_TMO])) break; if (_sp > XB_SPIN_CAP) { atomicAdd(&(bar)[XB_TMO], 1u); break; } } } } while (0)

struct XcdBarrier {
    unsigned* bar; unsigned x;
    volatile LAS unsigned* st;
};

__device__ __forceinline__ XcdBarrier xcd_barrier_post(unsigned* bar, volatile LAS unsigned* st) {
    XcdBarrier b; b.bar = bar; b.x = xb_xcc_id(); b.st = st;
    if (threadIdx.x == 0) (void)xb_add(&bar[XB_XCNT(b.x)], 1u);
    return b;
}
__device__ __forceinline__ void xcd_barrier_complete(unsigned* bar, unsigned x, unsigned& nloc, unsigned& nx) {
    const unsigned G = gridDim.x * gridDim.y * gridDim.z;
    unsigned sum, cnt, mine, sp = 0u;
    for (;;) {
        sum = 0u; cnt = 0u; mine = 0u;
#pragma unroll
        for (unsigned j = 0; j < 16; ++j) { const unsigned c = xb_ld(&bar[XB_XCNT(j)]); sum += c; cnt += (c > 0u) ? 1u : 0u; mine = (j == x) ? c : mine; }
        if (sum == G) break;
        __builtin_amdgcn_s_sleep(1);
        if ((++sp & 255u) == 0u) { if (xb_ld(&bar[XB_TMO])) break; if (sp > XB_SPIN_CAP) { atomicAdd(&bar[XB_TMO], 1u); break; } }
    }
    nloc = mine > 0u ? mine : 1u; nx = cnt > 0u ? cnt : 1u;
}

__device__ __forceinline__ void xcd_barrier(const XcdBarrier& b) {
    asm volatile("s_waitcnt vmcnt(0)" ::: "memory");
    __syncthreads();
    if (threadIdx.x == 0) {
        unsigned* bar = b.bar;
        __builtin_amdgcn_s_waitcnt(0);
        unsigned nloc = b.st[0], nx = b.st[1];
        if (nloc == 0u) { xcd_barrier_complete(bar, b.x, nloc, nx); b.st[0] = nloc; b.st[1] = nx; }
        const unsigned old = xb_add(&bar[XB_XSUB(b.x)], 1u);
        const unsigned gen = old / nloc;
        if (old + 1u == (gen + 1u) * nloc) {
            __builtin_amdgcn_fence(__ATOMIC_RELEASE, "agent");
            asm volatile("s_waitcnt vmcnt(0)" ::: "memory");
            const unsigned og = xb_add(&bar[XB_TOP], 1u);
            const unsigned tg = og / nx;
            if (og + 1u == (tg + 1u) * nx) xb_add(&bar[XB_TOPGEN], 1u);
            else XB_SPIN(xb_ld(&bar[XB_TOPGEN]) == tg, bar);
            __builtin_amdgcn_fence(__ATOMIC_ACQUIRE, "agent");
            xb_add(&bar[XB_XGEN(b.x)], 1u);
            asm volatile("s_waitcnt vmcnt(0)" ::: "memory");
        } else {
            XB_SPIN(xb_ld(&bar[XB_XGEN(b.x)]) == gen, bar);
            __builtin_amdgcn_fence(__ATOMIC_ACQUIRE, "agent");
            asm volatile("s_waitcnt vmcnt(0)" ::: "memory");
        }
    }
    __syncthreads();
}

#define XB_EXIT XCD_BAR_WORDS
__device__ unsigned g_barw[XCD_BAR_WORDS + 64];
constexpr int LDS_BYTES = 132096;

__global__ void __launch_bounds__(NTHREADS, 2) fwd_megakernel(Args a) {
    extern __shared__ __attribute__((aligned(16))) unsigned char lds_raw[];
    LAS unsigned char* lds = (LAS unsigned char*)lds_raw;
    cg::grid_group grid = cg::this_grid();
    const int tid = threadIdx.x, lane = tid & 63, wave = __builtin_amdgcn_readfirstlane(tid >> 6);
    const int G = gridDim.x, gw = blockIdx.x * NWAVES + wave, NGW = G * NWAVES;
    unsigned char* ws = a.ws;
    bf16_t* XN = (bf16_t*)(ws + WS_XN); bf16_t* PROJ = (bf16_t*)(ws + WS_PROJ); bf16_t* RAW = (bf16_t*)(ws + WS_QKVRAW);

    unsigned* barw = g_barw;
    if (tid < 2) ((volatile LAS unsigned*)(lds + 131072))[tid] = 0u;
    __syncthreads();
    const XcdBarrier bar = xcd_barrier_post(barw, (volatile LAS unsigned*)(lds + 131072));
    if (a.never) grid.sync();
    phase0(a, lds, gw, NGW, wave, lane);
    xcd_barrier(bar);
#define G1_PL() { pg8::Gemm g{(const bf16_t*)(ws + WS_PB), (const bf16_t*)(ws + WS_WPL), T, DM, PLE, PLE}; pg8::StaticOrder S; S.init(T, DM, G, (int)blockIdx.x); \
      pg8::EpiPl E{(bf16_t*)(ws + WS_PL), DM}; pg8::gemm_phase<pg8::EpiPl, pg8::StaticOrder, true, true>(lds, g, S, E); }
    if (blockIdx.x & 1) G1_PL();
    { pg8::Gemm g{XN, (const bf16_t*)(ws + WS_WIN), T, 1024, DM, DM}; pg8::StaticOrder S; S.init(T, 1024, G, (int)blockIdx.x);
      pg8::EpiBf16<0> E{PROJ, PP};
      pg8::gemm_phase<pg8::EpiBf16<0>, pg8::StaticOrder, true, true>(lds, g, S, E); }
    { pg8::Gemm g{XN, (const bf16_t*)(ws + WS_WIN) + (size_t)1024 * DM, T, 2048, DM, DM}; pg8::StaticOrder S; S.init(T, 2048, G, (int)blockIdx.x);
      pg8::EpiProjB E{PROJ, PP};
      pg8::gemm_phase<pg8::EpiProjB, pg8::StaticOrder, true, true>(lds, g, S, E); }
    if (!(blockIdx.x & 1)) G1_PL();
    xcd_barrier(bar);
    { pg8::Gemm g{PROJ, (const bf16_t*)(ws + WS_WUP), T, UPN, UPK, PP}; pg8::StaticOrder S; S.init(T, UPN, G, (int)blockIdx.x);
      pg8::EpiBf16<0> E{RAW, UPN};
      pg8::gemm_phase<pg8::EpiBf16<0>, pg8::StaticOrder, true, true>(lds, g, S, E); }
    { const int nunits = (T / 256) * (UPN / 256), idle0 = (nunits - G > 0 && nunits - G < G) ? nunits - G : 0;
      if ((int)blockIdx.x >= idle0) late_transposes(a, lds, ((int)blockIdx.x - idle0) * NWAVES + wave, (G - idle0) * NWAVES, wave, lane); }
    xcd_barrier(bar);
    phase4a(a, gw, NGW, lane);
    phase4b(a, lds, tid);
    xcd_barrier(bar);
    { const bf16_t* Qg = XN; const bf16_t* Kg = (const bf16_t*)(ws + WS_K); const bf16_t* Vtg = (const bf16_t*)(ws + WS_VT); bf16_t* Og = RAW;
      for (int c = blockIdx.x; c < 256; c += G) { const int bh = c & 7, pi = c >> 3;
          attn_unit(lds, Qg, Kg, Vtg, Og, bh, 63 - pi, tid, wave, lane);
          attn_unit(lds, Qg, Kg, Vtg, Og, bh, pi, tid, wave, lane); } }
    xcd_barrier(bar);
    phase6(a, gw, NGW, lane);
    xcd_barrier(bar);
    { pg8::Gemm g{XN, (const bf16_t*)(ws + WS_WO), T, DM, DM, DM}; pg8::StaticOrder S; S.init(T, DM, G, (int)blockIdx.x);
      pg8::EpiX1 E{a.x, a.out, (bf16_t*)(ws + WS_X1B), (float*)(ws + WS_ROWSQ), DM};
      pg8::gemm_phase<pg8::EpiX1, pg8::StaticOrder, true, true>(lds, g, S, E); }
    xcd_barrier(bar);
    { pg8::Gemm g{(const bf16_t*)(ws + WS_X1B), (const bf16_t*)(ws + WS_WPLG), T, DM, DM, DM}; pg8::StaticOrder S; S.init(T, DM, G, (int)blockIdx.x);
      pg8::EpiGateOut E{(const bf16_t*)(ws + WS_PL), (const bf16_t*)(ws + WS_X1B), a.out, (const float*)(ws + WS_ROWSQ), DM, EPS};
      pg8::gemm_phase<pg8::EpiGateOut, pg8::StaticOrder, true, true>(lds, g, S, E); }
    __syncthreads();
    { LAS unsigned* flag = (LAS unsigned*)(lds + 131072 + 16);
      if (tid == 0) flag[0] = (xb_add(&barw[XB_EXIT], 1u) == (unsigned)G - 1u) ? 1u : 0u;
      __syncthreads();
      if (flag[0]) { for (int i = tid; i < XCD_BAR_WORDS + 64; i += NTHREADS) __hip_atomic_store(&barw[i], 0u, __ATOMIC_RELAXED, __HIP_MEMORY_SCOPE_AGENT); } }
}

extern "C" void kernel_launch(void* const* d_in, const int* in_sizes, int n_in, void* d_out, int out_size, void* d_ws, size_t ws_size, hipStream_t stream) {
    static int grid = 0;
    if (grid == 0) {
        if (n_in != 18 || in_sizes[0] != T * DM || out_size != T * DM || ws_size < WS_END) { fprintf(stderr, "kernel_launch: unexpected shapes (n_in %d, in0 %d, out %d, ws %zu)\n", n_in, n_in > 0 ? in_sizes[0] : -1, out_size, ws_size); grid = -1; return; }
        int dev = 0, cus = 0, per_cu = 0;
        hipGetDevice(&dev); hipDeviceGetAttribute(&cus, hipDeviceAttributeMultiprocessorCount, dev);
        if (hipFuncSetAttribute((const void*)fwd_megakernel, hipFuncAttributeMaxDynamicSharedMemorySize, LDS_BYTES) != hipSuccess) { fprintf(stderr, "kernel_launch: hipFuncSetAttribute failed\n"); }
        if (hipOccupancyMaxActiveBlocksPerMultiprocessor(&per_cu, (const void*)fwd_megakernel, NTHREADS, LDS_BYTES) != hipSuccess || per_cu < 1) { fprintf(stderr, "kernel_launch: occupancy query says %d\n", per_cu); per_cu = 1; }
        (void)hipGetLastError();
        grid = cus * (per_cu > 1 ? 1 : per_cu);
        if (grid <= 0) grid = 256;
    }
    if (grid < 0) return;
    Args a{};
    a.x = (const float*)d_in[0]; a.p = (const float*)d_in[1]; a.pos = (const int*)d_in[2]; a.g_in = (const float*)d_in[3]; a.w_in = (const float*)d_in[4];
    a.g_cq = (const float*)d_in[5]; a.w_uq = (const float*)d_in[6]; a.g_ckv = (const float*)d_in[7]; a.w_ukv = (const float*)d_in[8];
    a.g_q = (const float*)d_in[9]; a.g_k = (const float*)d_in[10]; a.conv_w = (const float*)d_in[11]; a.g_oa = (const float*)d_in[12]; a.g_oc = (const float*)d_in[13];
    a.w_o = (const float*)d_in[14]; a.w_pl = (const float*)d_in[15]; a.w_plg = (const float*)d_in[16]; a.g_pl = (const float*)d_in[17];
    a.out = (float*)d_out; a.ws = (unsigned char*)d_ws;
    void* args[] = {&a};
    hipError_t e = hipLaunchCooperativeKernel((const void*)fwd_megakernel, dim3(grid), dim3(NTHREADS), args, LDS_BYTES, stream);
    if (e != hipSuccess) fprintf(stderr, "cooperative launch failed: %s (grid %d)\n", hipGetErrorString(e), grid);
}
```

```cpp
#include <hip/hip_runtime.h>
#include <hip/hip_cooperative_groups.h>
#include <cstdio>
#include <cstdint>
namespace cg = cooperative_groups;

typedef __bf16 bf16x2v_t __attribute__((ext_vector_type(2)));
typedef float f32x2_t __attribute__((ext_vector_type(2)));
__device__ __forceinline__ unsigned pk2(float a, float b) { f32x2_t v = {a, b}; bf16x2v_t r = __builtin_convertvector(v, bf16x2v_t); return __builtin_bit_cast(unsigned, r); }
__device__ __forceinline__ float bflo(unsigned u) { return __uint_as_float(u << 16); }
__device__ __forceinline__ float bfhi(unsigned u) { return __uint_as_float(u & 0xffff0000u); }
__device__ __forceinline__ float bf1(unsigned short u) { return __uint_as_float(((unsigned)u) << 16); }

namespace pg8 {
#define PG8_LAS __attribute__((address_space(3)))
typedef unsigned short bf16_t;
typedef short bf16x8 __attribute__((ext_vector_type(8)));
typedef float f32x4 __attribute__((ext_vector_type(4)));
typedef unsigned u32x4 __attribute__((ext_vector_type(4)));
constexpr int BM = 256, BK = 64, HALF = 128, HTB = HALF * BK * 2  , STAGE_BYTES = 8 * HTB, NXCD = 8, WGM = 8;

__host__ __device__ __forceinline__ int lds_byte(int r, int c) { const int st = (r >> 4) * 2 + (c >> 5), rr = r & 15, cc = c & 31, ob = rr * 64 + cc * 2; return st * 1024 + (ob ^ (((ob >> 9) & 1) << 5)); }
__host__ __device__ __forceinline__ void stage_rc(int b, int& R, int& C) { const int st = b / 1024, sb = b % 1024, swz = sb ^ (((sb >> 9) & 1) << 5); R = (st >> 1) * 16 + swz / 64; C = (st & 1) * 32 + (swz % 64) / 2; }
__host__ __device__ __forceinline__ int perm32(int rho) { const int n = rho >> 4, i = rho & 15; return 8 * (i >> 2) + 4 * n + (i & 3); }

struct Unit { int pm, pn; };
struct Gemm { const bf16_t* A; const bf16_t* Bt; int M, N, K, lda; };

struct StaticOrder {
    int nM, nN, nwg, G, c;
    __host__ __device__ void init(int M, int N, int G_, int c_) { nM = M / BM; nN = N / BM; nwg = nM * nN; G = G_; c = c_; }
    __host__ __device__ bool next(int i, Unit& u) const {
        const long L = (long)i * G + c; if (L >= nwg) return false;
        int wgid = (int)L; { const int q = nwg / NXCD, r = nwg % NXCD, xcd = wgid % NXCD, off = wgid / NXCD; wgid = (xcd < r ? xcd * (q + 1) : r * (q + 1) + (xcd - r) * q) + off; }
        const int nig = WGM * nN, gid = wgid / nig, fm = gid * WGM, gsz = (nM - fm) < WGM ? (nM - fm) : WGM;
        u.pm = fm + ((wgid % nig) % gsz); u.pn = (wgid % nig) / gsz; return true;
    }
    __device__ __forceinline__ void a_ready(const Unit&) const {}
    __device__ __forceinline__ void done(const Unit&) const {}
};


template <int ACT  > struct EpiBf16 {
    static constexpr bool PERM = true, AFTER_DRAIN = false;
    bf16_t* O; int ldc;
    __device__ __forceinline__ void operator()(const f32x4 (&acc)[2][2][4][2], const Unit& u, int wr, int wc, int fr, int fq) const {
        const int row0 = u.pm * BM + wr * 64 + fr; const int col0 = u.pn * BM + wc * 32 + 8 * fq;
#pragma unroll
        for (int ai = 0; ai < 2; ++ai)
#pragma unroll
            for (int m = 0; m < 4; ++m) { bf16_t* rowp = O + (size_t)(row0 + ai * HALF + m * 16) * ldc + col0;
#pragma unroll
                for (int bj = 0; bj < 2; ++bj) { f32x4 v0 = acc[ai][bj][m][0], v1 = acc[ai][bj][m][1];
                    if (ACT == 1) {
#pragma unroll
                        for (int e = 0; e < 4; ++e) { v0[e] = 1.f / (1.f + __expf(-v0[e])); v1[e] = 1.f / (1.f + __expf(-v1[e])); }
                    }
                    if (ACT == 2) {
                        const bool act = (u.pn >= 2);
#pragma unroll
                        for (int e = 0; e < 4; ++e) { const float s0 = v0[e] * __builtin_amdgcn_rcpf(1.f + __builtin_amdgcn_exp2f(-1.4426950408889634f * v0[e])), s1 = v1[e] * __builtin_amdgcn_rcpf(1.f + __builtin_amdgcn_exp2f(-1.4426950408889634f * v1[e]));
                            v0[e] = act ? s0 : v0[e]; v1[e] = act ? s1 : v1[e]; }
                    }
                    u32x4 w; w.x = pk2(v0[0], v0[1]); w.y = pk2(v0[2], v0[3]); w.z = pk2(v1[0], v1[1]); w.w = pk2(v1[2], v1[3]);
                    *(u32x4*)(rowp + bj * HALF) = w; } }
    }
};
struct EpiProjB {
    static constexpr bool PERM = false, AFTER_DRAIN = false;
    bf16_t* O; int ldc;
    __device__ __forceinline__ void operator()(const f32x4 (&acc)[2][2][4][2], const Unit& u, int wr, int wc, int fr, int fq) const {
        typedef unsigned u32x2 __attribute__((ext_vector_type(2)));
        const int row0 = u.pm * BM + wr * 64 + fr;
        const int ch0 = u.pn * 64 + 16 * wc + 4 * fq;
#pragma unroll
        for (int ai = 0; ai < 2; ++ai)
#pragma unroll
            for (int m = 0; m < 4; ++m) { bf16_t* rowp = O + (size_t)(row0 + ai * HALF + m * 16) * ldc + ch0;
                const f32x4 cb = acc[ai][0][m][0], zc = acc[ai][0][m][1], cc = acc[ai][1][m][0], cx = acc[ai][1][m][1]; f32x4 g, pr;
#pragma unroll
                for (int e = 0; e < 4; ++e) { g[e] = cb[e] * zc[e] * __builtin_amdgcn_rcpf(1.f + __builtin_amdgcn_exp2f(-1.4426950408889634f * zc[e])); pr[e] = cc[e] * cx[e]; }
                u32x2 w; w.x = pk2(g[0], g[1]); w.y = pk2(g[2], g[3]); *(u32x2*)(rowp + 1024) = w;
                w.x = pk2(pr[0], pr[1]); w.y = pk2(pr[2], pr[3]); *(u32x2*)(rowp + 1536) = w; }
    }
};
struct EpiX1 {
    static constexpr bool PERM = true, AFTER_DRAIN = false;
    const float* base; float* out; bf16_t* xb; float* rowsq; int ldc;
    __device__ __forceinline__ void operator()(const f32x4 (&acc)[2][2][4][2], const Unit& u, int wr, int wc, int fr, int fq) const {
        const int row0 = u.pm * BM + wr * 64 + fr; const int col0 = u.pn * BM + wc * 32 + 8 * fq;
#pragma unroll
        for (int ai = 0; ai < 2; ++ai)
#pragma unroll
            for (int m = 0; m < 4; ++m) { const int row = row0 + ai * HALF + m * 16; const size_t off = (size_t)row * ldc + col0; float s = 0.f;
#pragma unroll
                for (int bj = 0; bj < 2; ++bj) { const size_t o2 = off + bj * HALF;
                    const f32x4 v0 = *(const f32x4*)(base + o2) + acc[ai][bj][m][0], v1 = *(const f32x4*)(base + o2 + 4) + acc[ai][bj][m][1];
                    u32x4 w; w.x = pk2(v0[0], v0[1]); w.y = pk2(v0[2], v0[3]); w.z = pk2(v1[0], v1[1]); w.w = pk2(v1[2], v1[3]); *(u32x4*)(xb + o2) = w;
                    s += ((v0[0] * v0[0] + v0[1] * v0[1]) + (v0[2] * v0[2] + v0[3] * v0[3])) + ((v1[0] * v1[0] + v1[1] * v1[1]) + (v1[2] * v1[2] + v1[3] * v1[3])); }
                s += __shfl_xor(s, 16); s += __shfl_xor(s, 32);
                if (fq == 0) atomicAdd(rowsq + row, s);
                if (m & 1) asm volatile("" ::: "memory"); }
    }
};
struct EpiPl {
    static constexpr bool PERM = true, AFTER_DRAIN = false;
    bf16_t* pl; int ldc;
    __device__ __forceinline__ void operator()(const f32x4 (&acc)[2][2][4][2], const Unit& u, int wr, int wc, int fr, int fq) const {
        const int row0 = u.pm * BM + wr * 64 + fr; const int col0 = u.pn * BM + wc * 32 + 8 * fq;
#pragma unroll
        for (int ai = 0; ai < 2; ++ai)
#pragma unroll
            for (int m = 0; m < 4; ++m) { const size_t off = (size_t)(row0 + ai * HALF + m * 16) * ldc + col0;
#pragma unroll
                for (int bj = 0; bj < 2; ++bj) { const f32x4 v0 = acc[ai][bj][m][0], v1 = acc[ai][bj][m][1];
                    u32x4 w; w.x = pk2(v0[0], v0[1]); w.y = pk2(v0[2], v0[3]); w.z = pk2(v1[0], v1[1]); w.w = pk2(v1[2], v1[3]); *(u32x4*)(pl + off + bj * HALF) = w; } }
    }
};
struct EpiGateOut {
    static constexpr bool PERM = true, AFTER_DRAIN = false;
    const bf16_t* pl; const bf16_t* xb; float* out; const float* rowsq; int ldc; float eps;
    __device__ __forceinline__ void operator()(const f32x4 (&acc)[2][2][4][2], const Unit& u, int wr, int wc, int fr, int fq) const {
        const int row0 = u.pm * BM + wr * 64 + fr; const int col0 = u.pn * BM + wc * 32 + 8 * fq;
#pragma unroll
        for (int ai = 0; ai < 2; ++ai)
#pragma unroll
            for (int m = 0; m < 4; ++m) { const int row = row0 + ai * HALF + m * 16; const size_t off = (size_t)row * ldc + col0;
                const float nrl = -1.4426950408889634f * __builtin_amdgcn_rsqf(__hip_atomic_load(rowsq + row, __ATOMIC_RELAXED, __HIP_MEMORY_SCOPE_AGENT) * (1.f / (float)ldc) + eps);
#pragma unroll
                for (int bj = 0; bj < 2; ++bj) { const size_t o2 = off + bj * HALF; const u32x4 xw = *(const u32x4*)(xb + o2), g = *(const u32x4*)(pl + o2);
                    f32x4 b0, b1, p0, p1;
                    b0[0] = __uint_as_float(xw.x << 16); b0[1] = __uint_as_float(xw.x & 0xffff0000u); b0[2] = __uint_as_float(xw.y << 16); b0[3] = __uint_as_float(xw.y & 0xffff0000u);
                    b1[0] = __uint_as_float(xw.z << 16); b1[1] = __uint_as_float(xw.z & 0xffff0000u); b1[2] = __uint_as_float(xw.w << 16); b1[3] = __uint_as_float(xw.w & 0xffff0000u);
                    p0[0] = __uint_as_float(g.x << 16); p0[1] = __uint_as_float(g.x & 0xffff0000u); p0[2] = __uint_as_float(g.y << 16); p0[3] = __uint_as_float(g.y & 0xffff0000u);
                    p1[0] = __uint_as_float(g.z << 16); p1[1] = __uint_as_float(g.z & 0xffff0000u); p1[2] = __uint_as_float(g.w << 16); p1[3] = __uint_as_float(g.w & 0xffff0000u);
                    f32x4 s0, s1;
#pragma unroll
                    for (int e = 0; e < 4; ++e) { s0[e] = __builtin_amdgcn_rcpf(1.f + __builtin_amdgcn_exp2f(nrl * acc[ai][bj][m][0][e])); s1[e] = __builtin_amdgcn_rcpf(1.f + __builtin_amdgcn_exp2f(nrl * acc[ai][bj][m][1][e])); }
                    *(f32x4*)(out + o2) = b0 + s0 * p0; *(f32x4*)(out + o2 + 4) = b1 + s1 * p1; }
                if (m & 1) asm volatile("" ::: "memory"); }
    }
};

template <class Epi, class Sched, bool ALIGN_EPI = false, bool SP2 = false>
__device__ __forceinline__ void gemm_phase(PG8_LAS unsigned char* lds, const Gemm g, const Sched& S, const Epi& E) {
    int tid_ = threadIdx.x; asm volatile("" : "+v"(tid_));
    const int tid = tid_, wid = __builtin_amdgcn_readfirstlane(tid >> 6), lane = tid & 63, wr = wid >> 2, wc = wid & 3, fr = lane & 15, fq = lane >> 4;
    const int K = g.K, nt = K / BK;
    unsigned voffA[2], voffB[2];
#pragma unroll
    for (int i = 0; i < 2; ++i) { int R, C; stage_rc(tid * 16 + i * 8192, R, C); const int Rb = Epi::PERM ? ((R & ~31) + perm32(R & 31)) : R;
        voffA[i] = (unsigned)(R * g.lda + C) * 2u; voffB[i] = (unsigned)(Rb * K + C) * 2u; }
    const size_t kstep = (size_t)(BK * 2);
    const size_t hstepB = (size_t)HALF * K * 2, hstepA = (size_t)HALF * g.lda * 2;
    const size_t tstepB = 2 * hstepB, tstepA = 2 * hstepA;
    const unsigned ldsw = (unsigned)wid * 1024u;
    const int aoff = lds_byte(wr * 64 + fr, fq * 8), boff = lds_byte(wc * 32 + fr, fq * 8);
#define PG8_SA(b, h) (((b) * 2 + (h)) * HTB)
#define PG8_SB(b, h) ((4 + (b) * 2 + (h)) * HTB)
#define PG8_STAGE(bufoff, gbase, voff) do { _Pragma("unroll") for (int _i = 0; _i < 2; ++_i) \
        __builtin_amdgcn_global_load_lds((const unsigned*)((const char*)(gbase) + (voff)[_i]), (PG8_LAS unsigned*)(lds + (bufoff) + ldsw + _i * 8192), 16, 0, 0); } while (0)
#define PG8_LDA(dst, b, h) do { _Pragma("unroll") for (int m = 0; m < 4; ++m) _Pragma("unroll") for (int k = 0; k < 2; ++k) dst[m][k] = *(const PG8_LAS bf16x8*)(lds + PG8_SA(b, h) + aoff + m * 2048 + k * 1024); } while (0)
#define PG8_LDB(dst, b, h) do { _Pragma("unroll") for (int n = 0; n < 2; ++n) _Pragma("unroll") for (int k = 0; k < 2; ++k) dst[n][k] = *(const PG8_LAS bf16x8*)(lds + PG8_SB(b, h) + boff + n * 2048 + k * 1024); } while (0)
#define PG8_MMA(ai, bj, At, Bt) do { __builtin_amdgcn_s_setprio(1); _Pragma("unroll") for (int m = 0; m < 4; ++m) _Pragma("unroll") for (int n = 0; n < 2; ++n) _Pragma("unroll") for (int k = 0; k < 2; ++k) \
        acc[ai][bj][m][n] = __builtin_amdgcn_mfma_f32_16x16x32_bf16(Bt[n][k], At[m][k], acc[ai][bj][m][n], 0, 0, 0); __builtin_amdgcn_s_setprio(0); } while (0)
#define PG8_WAIT_V(n) asm volatile("s_waitcnt vmcnt(" #n ")" ::: "memory")
#define PG8_WAIT_L(n) asm volatile("s_waitcnt lgkmcnt(" #n ")" ::: "memory")
#define PG8_BAR __builtin_amdgcn_s_barrier()
#define PG8_SCHED __builtin_amdgcn_sched_barrier(0)
    Unit cur, nxt; int ui = 0;
    if (!S.next(0, cur)) return;
    f32x4 acc[2][2][4][2];
#pragma unroll
    for (int a = 0; a < 2; ++a)
#pragma unroll
        for (int b = 0; b < 2; ++b)
#pragma unroll
            for (int m = 0; m < 4; ++m)
#pragma unroll
                for (int n = 0; n < 2; ++n) acc[a][b][m][n] = (f32x4){0.f, 0.f, 0.f, 0.f};
    bf16x8 At[4][2], B0[2][2], B1[2][2];
    const char* cA = (const char*)g.A + (size_t)cur.pm * tstepA; const char* cB = (const char*)g.Bt + (size_t)cur.pn * tstepB;
    S.a_ready(cur);
    if constexpr (SP2) {
        PG8_STAGE(PG8_SB(0, 0), cB, voffB); PG8_STAGE(PG8_SB(0, 1), cB + hstepB, voffB); PG8_STAGE(PG8_SA(0, 0), cA, voffA); PG8_STAGE(PG8_SA(0, 1), cA + hstepA, voffA);
        if (wr == 1) PG8_BAR;
        PG8_WAIT_V(2); PG8_BAR;
        PG8_STAGE(PG8_SB(1, 0), cB + kstep, voffB); PG8_STAGE(PG8_SA(1, 0), cA + kstep, voffA); PG8_STAGE(PG8_SB(1, 1), cB + hstepB + kstep, voffB);
        PG8_WAIT_V(6); PG8_BAR;
    } else {
        PG8_STAGE(PG8_SB(0, 0), cB, voffB); PG8_STAGE(PG8_SA(0, 0), cA, voffA); PG8_STAGE(PG8_SB(0, 1), cB + hstepB, voffB); PG8_STAGE(PG8_SA(0, 1), cA + hstepA, voffA);
        if (wr == 1) PG8_BAR;
        PG8_WAIT_V(4); PG8_BAR;
        PG8_STAGE(PG8_SB(1, 0), cB + kstep, voffB); PG8_STAGE(PG8_SA(1, 0), cA + kstep, voffA); PG8_STAGE(PG8_SB(1, 1), cB + hstepB + kstep, voffB);
        PG8_WAIT_V(6); PG8_BAR;
    }
    for (;;) {
        const bool has_next = S.next(ui + 1, nxt);
        const char* nA = has_next ? (const char*)g.A + (size_t)nxt.pm * tstepA : cA; const char* nB = has_next ? (const char*)g.Bt + (size_t)nxt.pn * tstepB : cB;
        for (int t = 0; t < nt; t += 2) {
            const bool last = (t == nt - 2);
            const char* a1 = cA + (size_t)(t + 1) * kstep;
            const char* a2 = last ? nA : cA + (size_t)(t + 2) * kstep; const char* b2 = last ? nB : cB + (size_t)(t + 2) * kstep;
            const char* a3 = a2 + kstep; const char* b3 = b2 + kstep;
            if (last && has_next) S.a_ready(nxt);
            if constexpr (SP2) {
            PG8_LDB(B0, 0, 0); PG8_LDB(B1, 0, 1); PG8_SCHED; PG8_LDA(At, 0, 0); PG8_STAGE(PG8_SA(1, 1), a1 + hstepA, voffA);
            PG8_WAIT_V(8); PG8_WAIT_L(0); PG8_BAR; PG8_MMA(0, 0, At, B0); PG8_MMA(0, 1, At, B1); PG8_BAR; PG8_SCHED;
            PG8_LDA(At, 0, 1); PG8_STAGE(PG8_SB(0, 0), b2, voffB); PG8_STAGE(PG8_SB(0, 1), b2 + hstepB, voffB); PG8_STAGE(PG8_SA(0, 0), a2, voffA);
            PG8_WAIT_V(8); PG8_WAIT_L(0); PG8_BAR; PG8_MMA(1, 0, At, B0); PG8_MMA(1, 1, At, B1); PG8_BAR; PG8_SCHED;
            PG8_LDB(B0, 1, 0); PG8_LDB(B1, 1, 1); PG8_SCHED; PG8_LDA(At, 1, 0); PG8_STAGE(PG8_SA(0, 1), a2 + hstepA, voffA);
            PG8_WAIT_V(8); PG8_WAIT_L(0); PG8_BAR; PG8_MMA(0, 0, At, B0); PG8_MMA(0, 1, At, B1); PG8_BAR; PG8_SCHED;
            PG8_LDA(At, 1, 1); PG8_STAGE(PG8_SB(1, 0), b3, voffB); PG8_STAGE(PG8_SB(1, 1), b3 + hstepB, voffB); PG8_STAGE(PG8_SA(1, 0), a3, voffA);
            PG8_WAIT_V(8); PG8_WAIT_L(0); PG8_BAR; PG8_MMA(1, 0, At, B0); PG8_MMA(1, 1, At, B1); PG8_BAR; PG8_SCHED;
            } else {
            PG8_LDB(B0, 0, 0); PG8_SCHED; PG8_LDA(At, 0, 0); PG8_STAGE(PG8_SA(1, 1), a1 + hstepA, voffA);
            PG8_WAIT_L(8); PG8_BAR; PG8_WAIT_L(0); PG8_MMA(0, 0, At, B0); PG8_BAR; PG8_SCHED;
            PG8_LDB(B1, 0, 1); PG8_STAGE(PG8_SB(0, 0), b2, voffB);
            PG8_BAR; PG8_WAIT_L(0); PG8_MMA(0, 1, At, B1); PG8_BAR;
            PG8_LDA(At, 0, 1); PG8_STAGE(PG8_SA(0, 0), a2, voffA);
            PG8_BAR; PG8_WAIT_L(0); PG8_MMA(1, 0, At, B0); PG8_BAR; PG8_SCHED;
            PG8_STAGE(PG8_SB(0, 1), b2 + hstepB, voffB);
            PG8_WAIT_V(6); PG8_BAR; PG8_MMA(1, 1, At, B1); PG8_BAR;
            PG8_LDB(B0, 1, 0); PG8_SCHED; PG8_LDA(At, 1, 0); PG8_STAGE(PG8_SA(0, 1), a2 + hstepA, voffA);
            PG8_WAIT_L(8); PG8_BAR; PG8_WAIT_L(0); PG8_MMA(0, 0, At, B0); PG8_BAR; PG8_SCHED;
            PG8_LDB(B1, 1, 1); PG8_STAGE(PG8_SB(1, 0), b3, voffB);
            PG8_BAR; PG8_WAIT_L(0); PG8_MMA(0, 1, At, B1); PG8_BAR;
            PG8_LDA(At, 1, 1); PG8_STAGE(PG8_SA(1, 0), a3, voffA);
            PG8_BAR; PG8_WAIT_L(0); PG8_MMA(1, 0, At, B0); PG8_BAR; PG8_SCHED;
            PG8_STAGE(PG8_SB(1, 1), b3 + hstepB, voffB);
            PG8_WAIT_V(6); PG8_BAR; PG8_MMA(1, 1, At, B1); PG8_BAR;
            }
        }
        if constexpr (ALIGN_EPI) { if (wr == 0) PG8_BAR; }
        if constexpr (!Epi::AFTER_DRAIN) { int fr_ = fr, fq_ = fq; asm volatile("" : "+v"(fr_), "+v"(fq_));
            E(acc, cur, wr, wc, fr_, fq_); S.done(cur); }
        if (!has_next) break;
#pragma unroll
        for (int a = 0; a < 2; ++a)
#pragma unroll
            for (int b = 0; b < 2; ++b)
#pragma unroll
                for (int m = 0; m < 4; ++m)
#pragma unroll
                    for (int n = 0; n < 2; ++n) acc[a][b][m][n] = (f32x4){0.f, 0.f, 0.f, 0.f};
        cur = nxt; cA = nA; cB = nB; ++ui;
        if constexpr (ALIGN_EPI) { if (wr == 1) PG8_BAR; }
    }
    PG8_WAIT_V(0);
    if constexpr (!ALIGN_EPI) { if (wr == 0) PG8_BAR; }
    PG8_BAR;
    if constexpr (Epi::AFTER_DRAIN) { E.fused(acc, cur, wr, wc, fr, fq, lds, wid, lane); S.done(cur); }
#undef PG8_SA
#undef PG8_SB
#undef PG8_STAGE
#undef PG8_LDA
#undef PG8_LDB
#undef PG8_MMA
#undef PG8_WAIT_V
#undef PG8_WAIT_L
#undef PG8_BAR
#undef PG8_SCHED
}
}

constexpr int BATCH = 2, SEQ = 8192, DM = 1024, T = BATCH * SEQ;
constexpr int PLE = 256, NH = 4, NOPE = 128, ROPE = 64, VD = 128, QKD = 192, QLORA = 256, KVLORA = 128, AW = 512, CW = 512;
constexpr int INTOT = 3008, INPAD = 3072;
constexpr int PP = 2048;
constexpr int C_CQ = 0, C_CKV = 256, C_KPE = 384, C_ZA = 512, C_G = 1024, C_PR = 1536;
constexpr int UPK = 384, UPN = 1792;
constexpr float EPS = 1e-6f;
constexpr int NWAVES = 8, NTHREADS = 512;

constexpr size_t MiB = 1u << 20;
constexpr size_t WS_WIN = 0;
constexpr size_t WS_WUP = 6 * MiB;
constexpr size_t WS_WO = 8 * MiB;
constexpr size_t WS_WPLG = 10 * MiB;
constexpr size_t WS_WPL = 12 * MiB;
constexpr size_t WS_XN = 16 * MiB;
constexpr size_t WS_PB = 48 * MiB;
constexpr size_t WS_PROJ = 56 * MiB;
constexpr size_t WS_QKVRAW = 152 * MiB;
constexpr size_t WS_K = 208 * MiB;
constexpr size_t WS_VT = 232 * MiB;
constexpr size_t WS_END = 248 * MiB;
constexpr size_t WS_ROWSQ = 14 * MiB;
constexpr size_t WS_X1B = WS_PROJ;
constexpr size_t WS_PL = WS_PROJ + 64 * MiB;

#define LAS __attribute__((address_space(3)))
typedef unsigned short bf16_t;
typedef short bf16x8 __attribute__((ext_vector_type(8)));
typedef float f32x4 __attribute__((ext_vector_type(4)));
typedef float f32x16 __attribute__((ext_vector_type(16)));
typedef unsigned u32x4 __attribute__((ext_vector_type(4)));
typedef unsigned u32x2 __attribute__((ext_vector_type(2)));

struct Args {
    const float* x; const float* p; const int* pos; const float* g_in; const float* w_in; const float* g_cq; const float* w_uq; const float* g_ckv; const float* w_ukv;
    const float* g_q; const float* g_k; const float* conv_w; const float* g_oa; const float* g_oc; const float* w_o; const float* w_pl; const float* w_plg; const float* g_pl;
    float* out; unsigned char* ws; int never; int pad;
};

__device__ __forceinline__ float wave_sum(float v) {
#pragma unroll
    for (int o = 1; o < 64; o <<= 1) v += __shfl_xor(v, o);
    return v;
}
__device__ __forceinline__ float max_xor32(float x) { const u32x2 r = __builtin_amdgcn_permlane32_swap(__float_as_uint(x), __float_as_uint(x), false, false); return fmaxf(__uint_as_float(r.x), __uint_as_float(r.y)); }
__device__ __forceinline__ float silu_f(float z) { return z / (1.f + __expf(-z)); }

__device__ __forceinline__ int win_row(int n) {
    if (n < 448) return n;
    if (n < 960) return n + 64;
    const int t = n - 960, q = t >> 9, ch = t & 511, qn = (q == 0) ? 0 : (q == 1) ? 2 : (q == 2) ? 3 : 1, cg = ch >> 6, ci = ch & 63;
    return 1024 + 256 * cg + 128 * (qn >> 1) + 32 * (ci >> 4) + 16 * (qn & 1) + (ci & 15);
}
template <bool WINMAP = false>
__device__ __forceinline__ void p0_transpose_item(const float* W, int N, bf16_t* WT, int ldt, int row_off, int col_off, LAS float* scr, int item, int lane, const float* gk = nullptr) {
    const int nblk = N / 32, kb = item / nblk, nb = item % nblk, k0 = 64 * kb, n0 = 32 * nb;
    { f32x4 v[8];
#pragma unroll
      for (int i = 0; i < 8; ++i) v[i] = *(const f32x4*)(W + (size_t)(k0 + 8 * i + (lane >> 3)) * N + n0 + 4 * (lane & 7));
#pragma unroll
      for (int i = 0; i < 8; ++i) { const int kk = 8 * i + (lane >> 3); const float gg = gk ? gk[k0 + kk] : 1.f; LAS float* d = scr + kk * 33 + 4 * (lane & 7);
          d[0] = v[i][0] * gg; d[1] = v[i][1] * gg; d[2] = v[i][2] * gg; d[3] = v[i][3] * gg; } }
    asm volatile("s_waitcnt lgkmcnt(0)" ::: "memory");
    const int c = lane & 7;
#pragma unroll
    for (int j = 0; j < 4; ++j) { const int n = (lane >> 3) + 8 * j; const LAS float* s = scr + (8 * c) * 33 + n;
        u32x4 o; o.x = pk2(s[0 * 33], s[1 * 33]); o.y = pk2(s[2 * 33], s[3 * 33]); o.z = pk2(s[4 * 33], s[5 * 33]); o.w = pk2(s[6 * 33], s[7 * 33]);
        *(u32x4*)(WT + (size_t)(WINMAP ? win_row(n0 + n) : row_off + n0 + n) * ldt + col_off + k0 + 8 * c) = o; }
    asm volatile("s_waitcnt lgkmcnt(0)" ::: "memory");
}

__device__ __forceinline__ void phase0(const Args& a, LAS unsigned char* lds, int gw_, int NGW, int wave, int lane_) {
    int lane = lane_; asm volatile("" : "+v"(lane));
    const int gw = blockIdx.x * NWAVES + wave;
    unsigned char* ws = a.ws;
    bf16_t* WinT = (bf16_t*)(ws + WS_WIN); bf16_t* WupT = (bf16_t*)(ws + WS_WUP); bf16_t* WoT = (bf16_t*)(ws + WS_WO); bf16_t* WplgT = (bf16_t*)(ws + WS_WPLG); bf16_t* WplT = (bf16_t*)(ws + WS_WPL);
    LAS float* scr = (LAS float*)(lds + wave * 16384);
    constexpr int I_IN = (DM / 64) * (INTOT / 32), I_UQ = (QLORA / 64) * (768 / 32), I_UKV = (KVLORA / 64) * (1024 / 32), I_O = (DM / 64) * (DM / 32), I_PLG = I_O, I_PL = (PLE / 64) * (DM / 32);
    constexpr int NITEMS = I_IN + I_UQ + I_UKV + I_PL;
    (void)I_O; (void)I_PLG; (void)WoT; (void)WplgT;
    for (int it = gw; it < NITEMS; it += NGW) {
        int r = it;
        if (r < I_IN) { p0_transpose_item<true>(a.w_in, INTOT, WinT, DM, 0, 0, scr, r, lane); continue; } r -= I_IN;
        if (r < I_UQ) { p0_transpose_item(a.w_uq, 768, WupT, UPK, 0, 0, scr, r, lane, a.g_cq); continue; } r -= I_UQ;
        if (r < I_UKV) { p0_transpose_item(a.w_ukv, 1024, WupT, UPK, 768, 256, scr, r, lane, a.g_ckv); continue; } r -= I_UKV;
        p0_transpose_item(a.w_pl, DM, WplT, PLE, 0, 0, scr, r, lane);
    }
    const int gt = gw * 64 + lane, NGT = NGW * 64;
    for (int c = gt; c < (INPAD - INTOT) * DM / 8; c += NGT) *(u32x4*)(WinT + (size_t)448 * DM + (size_t)c * 8) = (u32x4){0u, 0u, 0u, 0u};
    for (int c = gt; c < UPN * (UPK / 8); c += NGT) { const int row = c / (UPK / 8), col = (c % (UPK / 8)) * 8; const bool diag = (row < 768) ? (col < 256) : (col >= 256);
        if (!diag) *(u32x4*)(WupT + (size_t)row * UPK + col) = (u32x4){0u, 0u, 0u, 0u}; }
    { float* rowsq = (float*)(ws + WS_ROWSQ); for (int c = gt; c < T; c += NGT) rowsq[c] = 0.f; }
    { bf16_t* PB = (bf16_t*)(ws + WS_PB);
      for (int c = gt; c < T * PLE / 8; c += NGT) { const f32x4 v0 = *(const f32x4*)(a.p + (size_t)c * 8), v1 = *(const f32x4*)(a.p + (size_t)c * 8 + 4);
          u32x4 o; o.x = pk2(v0[0], v0[1]); o.y = pk2(v0[2], v0[3]); o.z = pk2(v1[0], v1[1]); o.w = pk2(v1[2], v1[3]); *(u32x4*)(PB + (size_t)c * 8) = o; } }
    { bf16_t* XN = (bf16_t*)(ws + WS_XN);
      f32x4 g[4];
#pragma unroll
      for (int j = 0; j < 4; ++j) g[j] = *(const f32x4*)(a.g_in + 4 * lane + 256 * j);
      for (int m = gw; m < T; m += NGW) { const float* xr = a.x + (size_t)m * DM + 4 * lane; f32x4 v[4]; float s = 0.f;
#pragma unroll
          for (int j = 0; j < 4; ++j) { v[j] = *(const f32x4*)(xr + 256 * j); s += (v[j][0] * v[j][0] + v[j][1] * v[j][1]) + (v[j][2] * v[j][2] + v[j][3] * v[j][3]); }
          const float rstd = rsqrtf(wave_sum(s) * (1.f / DM) + EPS);
#pragma unroll
          for (int j = 0; j < 4; ++j) { const f32x4 o = v[j] * rstd * g[j]; u32x2 w; w.x = pk2(o[0], o[1]); w.y = pk2(o[2], o[3]); *(u32x2*)(XN + (size_t)m * DM + 4 * lane + 256 * j) = w; } } }
}

__device__ __forceinline__ void late_transposes(const Args& a, LAS unsigned char* lds, int rank_wave, int n_waves, int wave, int lane_) {
    int lane = lane_; asm volatile("" : "+v"(lane));
    bf16_t* WoT = (bf16_t*)(a.ws + WS_WO); bf16_t* WplgT = (bf16_t*)(a.ws + WS_WPLG);
    LAS float* scr = (LAS float*)(lds + wave * 16384);
    constexpr int I_O = (DM / 64) * (DM / 32);
    for (int it = rank_wave; it < 2 * I_O; it += n_waves) {
        if (it < I_O) p0_transpose_item(a.w_o, DM, WoT, DM, 0, 0, scr, it, lane);
        else p0_transpose_item(a.w_plg, DM, WplgT, DM, 0, 0, scr, it - I_O, lane, a.g_pl);
    }
}
struct TokIn { unsigned short q[4][3]; unsigned short k[4][2]; unsigned short kpe; u32x2 cq; unsigned ckv; int pos; };
__device__ __forceinline__ void p4_load(TokIn& t, const bf16_t* PROJ, const bf16_t* RAW, const int* pos, int m, int lane) {
    const bf16_t* pr = PROJ + (size_t)m * PP; const bf16_t* rr = RAW + (size_t)m * UPN;
#pragma unroll
    for (int h = 0; h < NH; ++h) {
#pragma unroll
        for (int i = 0; i < 3; ++i) t.q[h][i] = rr[h * QKD + lane + 64 * i];
#pragma unroll
        for (int i = 0; i < 2; ++i) t.k[h][i] = rr[768 + h * 256 + lane + 64 * i];
    }
    t.kpe = pr[C_KPE + lane]; t.cq = *(const u32x2*)(pr + C_CQ + 4 * lane); t.ckv = *(const unsigned*)(pr + C_CKV + 2 * lane); t.pos = pos[m];
}
__device__ __forceinline__ unsigned short bf16r(float v) { return (unsigned short)(pk2(v, 0.f) & 0xffffu); }
__device__ __forceinline__ void phase4a(const Args& a, int gw, int NGW, int lane_) {
    int lane = lane_; asm volatile("" : "+v"(lane));
    const bf16_t* PROJ = (const bf16_t*)(a.ws + WS_PROJ); const bf16_t* RAW = (const bf16_t*)(a.ws + WS_QKVRAW);
    bf16_t* Q = (bf16_t*)(a.ws + WS_XN); bf16_t* K = (bf16_t*)(a.ws + WS_K);
    const float gq0 = a.g_q[lane], gq1 = a.g_q[lane + 64], gq2 = a.g_q[lane + 128];
    const float gk0 = a.g_k[lane], gk1 = a.g_k[lane + 64], gk2 = a.g_k[lane + 128];
    const int fi = lane & 31; const float inv_freq = 1.0f / powf(10000.0f, (float)(2 * fi) / 64.0f);
    const float qscale = 0.07216878364870322f * 1.4426950408889634f;
    const float sgn = (lane < 32) ? -1.f : 1.f;
    TokIn cur, nxt; int m = gw;
    if (m < T) p4_load(cur, PROJ, RAW, a.pos, m, lane);
    for (; m < T; m += NGW) {
        const int mn = m + NGW; if (mn < T) p4_load(nxt, PROJ, RAW, a.pos, mn, lane);
        const int b = m / SEQ, s = m % SEQ;
        float qv[4][3], kv[4][2]; const float kpe = bf1(cur.kpe);
        float red[11];
        { const float c0 = bflo(cur.cq.x), c1 = bfhi(cur.cq.x), c2 = bflo(cur.cq.y), c3 = bfhi(cur.cq.y), d0 = bflo(cur.ckv), d1 = bfhi(cur.ckv);
          red[0] = (c0 * c0 + c1 * c1) + (c2 * c2 + c3 * c3); red[1] = d0 * d0 + d1 * d1; red[2] = kpe * kpe; }
#pragma unroll
        for (int h = 0; h < NH; ++h) { qv[h][0] = bf1(cur.q[h][0]); qv[h][1] = bf1(cur.q[h][1]); qv[h][2] = bf1(cur.q[h][2]); kv[h][0] = bf1(cur.k[h][0]); kv[h][1] = bf1(cur.k[h][1]);
            red[3 + h] = qv[h][0] * qv[h][0] + qv[h][1] * qv[h][1] + qv[h][2] * qv[h][2]; red[7 + h] = kv[h][0] * kv[h][0] + kv[h][1] * kv[h][1]; }
#pragma unroll
        for (int o = 1; o < 64; o <<= 1) {
#pragma unroll
            for (int e = 0; e < 11; ++e) red[e] += __shfl_xor(red[e], o);
        }
        const float rq = rsqrtf(red[0] * (1.f / QLORA) + EPS), rkv = rsqrtf(red[1] * (1.f / KVLORA) + EPS);
        const float ang = (float)cur.pos * inv_freq; float sn, cs; sincosf(ang, &sn, &cs);
        const float kp = kpe * gk2; const float kpo = __shfl_xor(kp, 32); const float kprope = kp * cs + sgn * kpo * sn;
#pragma unroll
        for (int h = 0; h < NH; ++h) {
            const float rs = rsqrtf(rq * rq * red[3 + h] * (1.f / QKD) + EPS) * rq * qscale;
            const float v0 = qv[h][0] * rs * gq0, v1 = qv[h][1] * rs * gq1, v2 = qv[h][2] * rs * gq2;
            const float o2 = __shfl_xor(v2, 32); const float r2 = v2 * cs + sgn * o2 * sn;
            bf16_t* qo = Q + ((size_t)(b * NH + h) * SEQ + s) * QKD;
            qo[lane] = bf16r(v0); qo[lane + 64] = bf16r(v1); qo[lane + 128] = bf16r(r2);
            const float rk = rsqrtf((rkv * rkv * red[7 + h] + red[2]) * (1.f / QKD) + EPS);
            bf16_t* ko = K + ((size_t)(b * NH + h) * SEQ + s) * QKD;
            ko[lane] = bf16r(kv[h][0] * rkv * rk * gk0); ko[lane + 64] = bf16r(kv[h][1] * rkv * rk * gk1); ko[lane + 128] = bf16r(kprope * rk);
        }
        cur = nxt;
    }
}
__device__ __forceinline__ void phase4b(const Args& a, LAS unsigned char* lds, int tid_) {
    int tid = tid_; asm volatile("" : "+v"(tid));
    const bf16_t* PROJ = (const bf16_t*)(a.ws + WS_PROJ); const bf16_t* RAW = (const bf16_t*)(a.ws + WS_QKVRAW); bf16_t* VT = (bf16_t*)(a.ws + WS_VT);
    constexpr int PITCH = 1040;
    LAS float* rkl = (LAS float*)(lds + 64 * PITCH);
    const int lane = tid & 63, wave = tid >> 6;
    for (int tile = blockIdx.x; tile < T / 64; tile += gridDim.x) {
        const int row0 = tile * 64;
        { float red[8];
#pragma unroll
          for (int e = 0; e < 8; ++e) { const unsigned c = *(const unsigned*)(PROJ + (size_t)(row0 + wave * 8 + e) * PP + C_CKV + 2 * lane); const float d0 = bflo(c), d1 = bfhi(c); red[e] = d0 * d0 + d1 * d1; }
#pragma unroll
          for (int o = 1; o < 64; o <<= 1) {
#pragma unroll
              for (int e = 0; e < 8; ++e) red[e] += __shfl_xor(red[e], o);
          }
#pragma unroll
          for (int e = 0; e < 8; ++e) if (lane == e) rkl[wave * 8 + e] = rsqrtf(red[e] * (1.f / KVLORA) + EPS); }
#pragma unroll
        for (int i = 0; i < 8; ++i) { const int c = tid + 512 * i, tok = c >> 6, rem = c & 63, h = rem >> 4, part = rem & 15;
            const u32x4 v = *(const u32x4*)(RAW + (size_t)(row0 + tok) * UPN + 768 + h * 256 + 128 + part * 8);
            *(LAS u32x4*)(lds + tok * PITCH + (h * 128 + part * 8) * 2) = v; }
        __syncthreads();
        const int b = row0 / SEQ, s0 = row0 % SEQ, ch = tid & 7;
        int key[8];
#pragma unroll
        for (int e = 0; e < 8; ++e) { const int p = ch * 8 + e, q = p & 15; key[e] = 16 * (p >> 4) + 8 * ((q & 7) >> 2) + 4 * (q >> 3) + (q & 3); }
        float rk[8];
#pragma unroll
        for (int e = 0; e < 8; ++e) rk[e] = rkl[key[e]];
#pragma unroll
        for (int i = 0; i < 8; ++i) {
            const int row = (tid >> 3) + 64 * i, h = row >> 7, d = row & 127;
            unsigned w[4];
#pragma unroll
            for (int e = 0; e < 4; ++e) {
                const float lo = bf1(*(const LAS unsigned short*)(lds + key[2 * e] * PITCH + row * 2)) * rk[2 * e], hi = bf1(*(const LAS unsigned short*)(lds + key[2 * e + 1] * PITCH + row * 2)) * rk[2 * e + 1];
                w[e] = pk2(lo, hi);
            }
            *(u32x4*)(VT + ((size_t)(b * NH + h) * VD + d) * SEQ + s0 + ch * 8) = (u32x4){w[0], w[1], w[2], w[3]};
        }
        __syncthreads();
    }
}

#define MFMA32(a, b, c) __builtin_amdgcn_mfma_f32_32x32x16_bf16((a), (b), (c), 0, 0, 0)
constexpr int KTILE = 64 * QKD * 2  , VTILE = VD * 64 * 2  , KRING = 0, VRING = 3 * KTILE;
#define ATT_DMA(gptr, ldsoff) __builtin_amdgcn_global_load_lds((const unsigned*)(gptr), (LAS unsigned*)(lds + (ldsoff)), 16, 0, 0)
#define ATT_ISSUE_K(jt, stage) do { _Pragma("unroll") for (int i_ = 0; i_ < 3; ++i_) ATT_DMA(kg + (size_t)(jt) * KTILE + kgo[i_], KRING + (stage) * KTILE + (wave * 3 + i_) * 1024); } while (0)
#define ATT_ISSUE_V(jt, stage) do { _Pragma("unroll") for (int i_ = 0; i_ < 2; ++i_) ATT_DMA(vg + (size_t)(jt) * 128 + vgo[i_], VRING + (stage) * VTILE + (wave * 2 + i_) * 1024); } while (0)

__device__ __forceinline__ void attn_unit(LAS unsigned char* lds, const bf16_t* Qg, const bf16_t* Kg, const bf16_t* Vtg, bf16_t* Og, int bh, int qb, int tid_, int wave, int lane_) {
    int tid = tid_; asm volatile("" : "+v"(tid));
    const int lane = tid & 63;
    const int rg = wave & 3, kh = wave >> 2, r = lane & 31, hi = lane >> 5;
    const int b = bh >> 2, h = bh & 3;
    const int nt = 2 * (qb + 1);
    const float NEG = -1e30f;
    bf16x8 qf[12];
    { const bf16_t* qp = Qg + ((size_t)bh * SEQ + 128 * qb + 32 * rg + r) * QKD + 8 * hi;
#pragma unroll
      for (int kk = 0; kk < 12; ++kk) qf[kk] = *(const bf16x8*)(qp + 16 * kk); }
    const unsigned char* kg = (const unsigned char*)(Kg + (size_t)bh * SEQ * QKD);
    const unsigned char* vg = (const unsigned char*)(Vtg + (size_t)bh * VD * SEQ);
    unsigned kgo[3], vgo[2];
#pragma unroll
    for (int i = 0; i < 3; ++i) { const int a = (wave * 3 + i) * 1024 + lane * 16, row = a / 384, cp = (a % 384) >> 4, cl = (cp & ~7) | ((cp ^ (row >> 1)) & 7); kgo[i] = (unsigned)(row * 384 + cl * 16); }
#pragma unroll
    for (int i = 0; i < 2; ++i) { const int a = (wave * 2 + i) * 1024 + lane * 16, row = a >> 7, cp = (a & 127) >> 4, cl = (cp ^ (row >> 1)) & 7; vgo[i] = (unsigned)(row * (SEQ * 2) + cl * 16); }
    const int sw = (r >> 1) & 7;
    unsigned kro[4], vro[2];
#pragma unroll
    for (int q = 0; q < 4; ++q) kro[q] = (unsigned)((32 * kh + r) * 384 + (((2 * q + hi) ^ sw) * 16));
#pragma unroll
    for (int s = 0; s < 2; ++s) vro[s] = (unsigned)(VRING + r * 128 + (((4 * kh + 2 * s + hi) ^ sw) * 16));
    f32x16 o[4]; float mrun = NEG, lrun = 0.f;
#pragma unroll
    for (int dt = 0; dt < 4; ++dt)
#pragma unroll
        for (int i = 0; i < 16; ++i) o[dt][i] = 0.f;
    ATT_ISSUE_K(0, 0); ATT_ISSUE_V(0, 0); ATT_ISSUE_K(1, 1);
    ATT_ISSUE_K((2 < nt) ? 2 : nt - 1, 2); ATT_ISSUE_V(1, 1);
    asm volatile("s_waitcnt vmcnt(5)" ::: "memory"); __builtin_amdgcn_s_barrier(); asm volatile("" ::: "memory");
    f32x16 sc, sn;
    {
#pragma unroll
      for (int i = 0; i < 16; ++i) sc[i] = 0.f;
#pragma unroll
      for (int kk = 0; kk < 12; ++kk) { const bf16x8 kf = *(const LAS bf16x8*)(lds + KRING + kro[kk & 3] + (kk >> 2) * 128); sc = MFMA32(kf, qf[kk], sc); if ((kk & 3) == 3) __builtin_amdgcn_sched_barrier(0); } }
    asm volatile("s_waitcnt lgkmcnt(0)" ::: "memory"); __builtin_amdgcn_s_barrier(); asm volatile("" ::: "memory");
    const float NINF = -__builtin_inff();
    int s0 = 0, s1 = 1, s2 = 2;
    for (int j = 0; j < nt; ++j) {
        const int relc = 64 * (j - 2 * qb) + 32 * kh - 32 * rg;
        const int j3 = (j + 3 < nt) ? j + 3 : nt - 1, j2 = (j + 2 < nt) ? j + 2 : nt - 1;
        const LAS unsigned char* kb = lds + KRING + s1 * KTILE;
        const LAS unsigned char* vb = lds + s0 * VTILE;
        if (relc >= 0) {
            const int thr = (relc == 0) ? r : -1;
#pragma unroll
            for (int i = 0; i < 16; ++i) { const int key = (i & 3) + 8 * (i >> 2) + 4 * hi; if (key > thr) sc[i] = NINF; }
        }
#define ATT_KRD(dst, g) do { _Pragma("unroll") for (int q_ = 0; q_ < 4; ++q_) dst[q_] = *(const LAS bf16x8*)(kb + kro[q_] + (g) * 128); } while (0)
        bf16x8 fa[4], fb[4];
        ATT_KRD(fa, 0); ATT_KRD(fb, 1);
#pragma unroll
        for (int i = 0; i < 16; ++i) sn[i] = 0.f;
        float mx = sc[0];
#pragma unroll
        for (int i = 1; i < 16; ++i) mx = fmaxf(mx, sc[i]);
        mx = max_xor32(mx);
        __builtin_amdgcn_sched_barrier(0);
#pragma unroll
        for (int q = 0; q < 4; ++q) sn = MFMA32(fa[q], qf[q], sn);
        ATT_KRD(fa, 2);
        __builtin_amdgcn_sched_barrier(0);
        if (__builtin_amdgcn_ballot_w64(mx > mrun + 8.f) != 0ull) {
            const float mnew = fmaxf(mrun, mx); const float alpha = __builtin_amdgcn_exp2f(mrun - mnew); mrun = mnew; lrun *= alpha;
#pragma unroll
            for (int dt = 0; dt < 4; ++dt) o[dt] = o[dt] * alpha;
        }
        float ps = 0.f; u32x4 p0, p1;
#pragma unroll
        for (int q = 0; q < 4; ++q) sn = MFMA32(fb[q], qf[4 + q], sn);
#pragma unroll
        for (int i = 0; i < 8; ++i) { sc[i] = __builtin_amdgcn_exp2f(sc[i] - mrun); ps += sc[i]; }
        p0.x = pk2(sc[0], sc[1]); p0.y = pk2(sc[2], sc[3]); p0.z = pk2(sc[4], sc[5]); p0.w = pk2(sc[6], sc[7]);
        __builtin_amdgcn_sched_barrier(0);
        ATT_ISSUE_K(j3, s0);
        __builtin_amdgcn_sched_barrier(0);
#pragma unroll
        for (int dt = 0; dt < 4; ++dt) fb[dt] = *(const LAS bf16x8*)(vb + vro[0] + dt * 4096);
#pragma unroll
        for (int q = 0; q < 4; ++q) sn = MFMA32(fa[q], qf[8 + q], sn);
#pragma unroll
        for (int i = 8; i < 12; ++i) { sc[i] = __builtin_amdgcn_exp2f(sc[i] - mrun); ps += sc[i]; }
        p1.x = pk2(sc[8], sc[9]); p1.y = pk2(sc[10], sc[11]);
        __builtin_amdgcn_sched_barrier(0);
        ATT_ISSUE_V(j2, s2);
        __builtin_amdgcn_sched_barrier(0);
#pragma unroll
        for (int dt = 0; dt < 4; ++dt) fa[dt] = *(const LAS bf16x8*)(vb + vro[1] + dt * 4096);
        { const bf16x8 pf0 = __builtin_bit_cast(bf16x8, p0);
          o[0] = MFMA32(fb[0], pf0, o[0]); o[1] = MFMA32(fb[1], pf0, o[1]); o[2] = MFMA32(fb[2], pf0, o[2]); o[3] = MFMA32(fb[3], pf0, o[3]); }
#pragma unroll
        for (int i = 12; i < 16; ++i) { sc[i] = __builtin_amdgcn_exp2f(sc[i] - mrun); ps += sc[i]; }
        p1.z = pk2(sc[12], sc[13]); p1.w = pk2(sc[14], sc[15]);
        lrun += ps;
        __builtin_amdgcn_sched_barrier(0);
        { const bf16x8 pf1 = __builtin_bit_cast(bf16x8, p1);
          o[0] = MFMA32(fa[0], pf1, o[0]); o[1] = MFMA32(fa[1], pf1, o[1]); o[2] = MFMA32(fa[2], pf1, o[2]); o[3] = MFMA32(fa[3], pf1, o[3]); }
        asm volatile("s_waitcnt vmcnt(5) lgkmcnt(0)" ::: "memory"); __builtin_amdgcn_s_barrier(); asm volatile("" ::: "memory");
        sc = sn;
        { const int t = s0; s0 = s1; s1 = s2; s2 = t; }
    }
    asm volatile("s_waitcnt vmcnt(0) lgkmcnt(0)" ::: "memory"); __builtin_amdgcn_s_barrier(); asm volatile("" ::: "memory");
    LAS float* cs = (LAS float*)(lds + rg * (66 * 64 * 4)) + lane;
    if (kh == 1) {
#pragma unroll
        for (int dt = 0; dt < 4; ++dt)
#pragma unroll
            for (int i = 0; i < 16; ++i) cs[(dt * 16 + i) * 64] = o[dt][i];
        cs[64 * 64] = mrun; cs[65 * 64] = lrun;
    }
    __syncthreads();
    if (kh == 0) {
        const float m1 = cs[64 * 64], l1 = cs[65 * 64];
        const float mf = fmaxf(mrun, m1), a0 = __builtin_amdgcn_exp2f(mrun - mf), a1 = __builtin_amdgcn_exp2f(m1 - mf);
        float lt = lrun * a0 + l1 * a1; lt += __shfl_xor(lt, 32);
        const float inv = 1.f / lt;
        bf16_t* op = Og + ((size_t)b * SEQ + 128 * qb + 32 * rg + r) * AW + h * VD + 4 * hi;
#pragma unroll
        for (int dt = 0; dt < 4; ++dt)
#pragma unroll
            for (int g = 0; g < 4; ++g) {
                float v[4];
#pragma unroll
                for (int e = 0; e < 4; ++e) v[e] = (o[dt][4 * g + e] * a0 + cs[(dt * 16 + 4 * g + e) * 64] * a1) * inv;
                u32x2 w; w.x = pk2(v[0], v[1]); w.y = pk2(v[2], v[3]);
                *(u32x2*)(op + 32 * dt + 8 * g) = w;
            }
    }
    __syncthreads();
}

__device__ __forceinline__ void unpack8(const u32x4 v, float (&f)[8]) { f[0] = bflo(v.x); f[1] = bfhi(v.x); f[2] = bflo(v.y); f[3] = bfhi(v.y); f[4] = bflo(v.z); f[5] = bfhi(v.z); f[6] = bflo(v.w); f[7] = bfhi(v.w); }
struct Tok6 { u32x4 o, za, g, pr; };
__device__ __forceinline__ void p6_load(Tok6& t, const bf16_t* PROJ, const bf16_t* O, int m, int c0) {
    const bf16_t* pr = PROJ + (size_t)m * PP;
    t.o = *(const u32x4*)(O + (size_t)m * AW + c0); t.za = *(const u32x4*)(pr + C_ZA + c0); t.g = *(const u32x4*)(pr + C_G + c0); t.pr = *(const u32x4*)(pr + C_PR + c0);
}
__device__ __forceinline__ void phase6(const Args& a, int gw, int NGW, int lane_) {
    int lane = lane_; asm volatile("" : "+v"(lane));
    const bf16_t* PROJ = (const bf16_t*)(a.ws + WS_PROJ); const bf16_t* O = (const bf16_t*)(a.ws + WS_QKVRAW); bf16_t* Y = (bf16_t*)(a.ws + WS_XN);
    const int c0 = 8 * lane;
    float goa[8], goc[8], w0[8], w1[8], w2[8];
#pragma unroll
    for (int e = 0; e < 8; ++e) { goa[e] = a.g_oa[c0 + e]; goc[e] = a.g_oc[c0 + e]; w0[e] = a.conv_w[c0 + e]; w1[e] = a.conv_w[CW + c0 + e]; w2[e] = a.conv_w[2 * CW + c0 + e]; }
    for (int ch = gw; ch < T / 8; ch += NGW) {
        const int m0 = ch * 8, s0 = m0 % SEQ;
        float pm2[8], pm1[8];
        if (s0 >= 2) { unpack8(*(const u32x4*)(PROJ + (size_t)(m0 - 1) * PP + C_PR + c0), pm1); unpack8(*(const u32x4*)(PROJ + (size_t)(m0 - 2) * PP + C_PR + c0), pm2); }
        else {
#pragma unroll
            for (int e = 0; e < 8; ++e) { pm1[e] = 0.f; pm2[e] = 0.f; }
        }
        Tok6 cur, nxt; p6_load(cur, PROJ, O, m0, c0);
#pragma unroll 1
        for (int i = 0; i < 8; ++i) {
            const int m = m0 + i;
            if (i < 7) p6_load(nxt, PROJ, O, m + 1, c0);
            float ov[8], za[8], gg[8], p0[8], v[8], u[8];
            unpack8(cur.o, ov); unpack8(cur.za, za); unpack8(cur.g, gg); unpack8(cur.pr, p0);
            float ss = 0.f, s2 = 0.f;
#pragma unroll
            for (int e = 0; e < 8; ++e) { v[e] = ov[e] * silu_f(za[e]); ss += v[e] * v[e];
                u[e] = gg[e] * (w2[e] * p0[e] + w1[e] * pm1[e] + w0[e] * pm2[e]); s2 += u[e] * u[e]; pm2[e] = pm1[e]; pm1[e] = p0[e]; }
#pragma unroll
            for (int o = 1; o < 64; o <<= 1) { ss += __shfl_xor(ss, o); s2 += __shfl_xor(s2, o); }
            const float rs = rsqrtf(ss * (1.f / AW) + EPS), rc = rsqrtf(s2 * (1.f / CW) + EPS);
            u32x4 w; w.x = pk2(v[0] * rs * goa[0], v[1] * rs * goa[1]); w.y = pk2(v[2] * rs * goa[2], v[3] * rs * goa[3]); w.z = pk2(v[4] * rs * goa[4], v[5] * rs * goa[5]); w.w = pk2(v[6] * rs * goa[6], v[7] * rs * goa[7]);
            *(u32x4*)(Y + (size_t)m * DM + c0) = w;
            w.x = pk2(u[0] * rc * goc[0], u[1] * rc * goc[1]); w.y = pk2(u[2] * rc * goc[2], u[3] * rc * goc[3]); w.z = pk2(u[4] * rc * goc[4], u[5] * rc * goc[5]); w.w = pk2(u[6] * rc * goc[6], u[7] * rc * goc[7]);
            *(u32x4*)(Y + (size_t)m * DM + AW + c0) = w;
            cur = nxt;
        }
    }
}

#define XB_TMO      128
#define XB_XCNT(j)  (256  + 64 * (j))
#define XB_XSUB(j)  (1280 + 64 * (j))
#define XB_XGEN(j)  (2304 + 64 * (j))
#define XB_TOP      3328
#define XB_TOPGEN   3392
#define XCD_BAR_WORDS 3456
#define XB_SPIN_CAP (1u << 18)

__device__ __forceinline__ unsigned xb_ld(unsigned* p)              { return __hip_atomic_load(p, __ATOMIC_RELAXED, __HIP_MEMORY_SCOPE_AGENT); }
__device__ __forceinline__ unsigned xb_add(unsigned* p, unsigned v) { return __hip_atomic_fetch_add(p, v, __ATOMIC_RELAXED, __HIP_MEMORY_SCOPE_AGENT); }
__device__ __forceinline__ unsigned xb_xcc_id() { return (unsigned)__builtin_amdgcn_s_getreg((3 << 11) | 20) & 0xFu; }
#define XB_SPIN(cond, bar) do { unsigned _sp = 0; while (cond) { __builtin_amdgcn_s_sleep(1); \
    if ((++_sp & 255u) == 0u) { if (xb_ld(&(bar)[XB_TMO])) break; if (_sp > XB_SPIN_CAP) { atomicAdd(&(bar)[XB_TMO], 1u); break; } } } } while (0)

struct XcdBarrier {
    unsigned* bar; unsigned x;
    volatile LAS unsigned* st;
};

__device__ __forceinline__ XcdBarrier xcd_barrier_post(unsigned* bar, volatile LAS unsigned* st) {
    XcdBarrier b; b.bar = bar; b.x = xb_xcc_id(); b.st = st;
    if (threadIdx.x == 0) (void)xb_add(&bar[XB_XCNT(b.x)], 1u);
    return b;
}
__device__ __forceinline__ void xcd_barrier_complete(unsigned* bar, unsigned x, unsigned& nloc, unsigned& nx) {
    const unsigned G = gridDim.x * gridDim.y * gridDim.z;
    unsigned sum, cnt, mine, sp = 0u;
    for (;;) {
        sum = 0u; cnt = 0u; mine = 0u;
#pragma unroll
        for (unsigned j = 0; j < 16; ++j) { const unsigned c = xb_ld(&bar[XB_XCNT(j)]); sum += c; cnt += (c > 0u) ? 1u : 0u; mine = (j == x) ? c : mine; }
        if (sum == G) break;
        __builtin_amdgcn_s_sleep(1);
        if ((++sp & 255u) == 0u) { if (xb_ld(&bar[XB_TMO])) break; if (sp > XB_SPIN_CAP) { atomicAdd(&bar[XB_TMO], 1u); break; } }
    }
    nloc = mine > 0u ? mine : 1u; nx = cnt > 0u ? cnt : 1u;
}

__device__ __forceinline__ void xcd_barrier(const XcdBarrier& b) {
    asm volatile("s_waitcnt vmcnt(0)" ::: "memory");
    __syncthreads();
    if (threadIdx.x == 0) {
        unsigned* bar = b.bar;
        __builtin_amdgcn_s_waitcnt(0);
        unsigned nloc = b.st[0], nx = b.st[1];
        if (nloc == 0u) { xcd_barrier_complete(bar, b.x, nloc, nx); b.st[0] = nloc; b.st[1] = nx; }
        const unsigned old = xb_add(&bar[XB_XSUB(b.x)], 1u);
        const unsigned gen = old / nloc;
        if (old + 1u == (gen + 1u) * nloc) {
            __builtin_amdgcn_fence(__ATOMIC_RELEASE, "agent");
            asm volatile("s_waitcnt vmcnt(0)" ::: "memory");
            const unsigned og = xb_add(&bar[XB_TOP], 1u);
            const unsigned tg = og / nx;
            if (og + 1u == (tg + 1u) * nx) xb_add(&bar[XB_TOPGEN], 1u);
            else XB_SPIN(xb_ld(&bar[XB_TOPGEN]) == tg, bar);
            __builtin_amdgcn_fence(__ATOMIC_ACQUIRE, "agent");
            xb_add(&bar[XB_XGEN(b.x)], 1u);
            asm volatile("s_waitcnt vmcnt(0)" ::: "memory");
        } else {
            XB_SPIN(xb_ld(&bar[XB_XGEN(b.x)]) == gen, bar);
            __builtin_amdgcn_fence(__ATOMIC_ACQUIRE, "agent");
            asm volatile("s_waitcnt vmcnt(0)" ::: "memory");
        }
    }
    __syncthreads();
}

#define XB_EXIT XCD_BAR_WORDS
__device__ unsigned g_barw[XCD_BAR_WORDS + 64];
constexpr int LDS_BYTES = 132096;

__global__ void __launch_bounds__(NTHREADS, 2) fwd_megakernel(Args a) {
    extern __shared__ __attribute__((aligned(16))) unsigned char lds_raw[];
    LAS unsigned char* lds = (LAS unsigned char*)lds_raw;
    cg::grid_group grid = cg::this_grid();
    const int tid = threadIdx.x, lane = tid & 63, wave = __builtin_amdgcn_readfirstlane(tid >> 6);
    const int G = gridDim.x, gw = blockIdx.x * NWAVES + wave, NGW = G * NWAVES;
    unsigned char* ws = a.ws;
    bf16_t* XN = (bf16_t*)(ws + WS_XN); bf16_t* PROJ = (bf16_t*)(ws + WS_PROJ); bf16_t* RAW = (bf16_t*)(ws + WS_QKVRAW);

    unsigned* barw = g_barw;
    if (tid < 2) ((volatile LAS unsigned*)(lds + 131072))[tid] = 0u;
    __syncthreads();
    const XcdBarrier bar = xcd_barrier_post(barw, (volatile LAS unsigned*)(lds + 131072));
    if (a.never) grid.sync();
    phase0(a, lds, gw, NGW, wave, lane);
    xcd_barrier(bar);
#define G1_PL() { pg8::Gemm g{(const bf16_t*)(ws + WS_PB), (const bf16_t*)(ws + WS_WPL), T, DM, PLE, PLE}; pg8::StaticOrder S; S.init(T, DM, G, (int)blockIdx.x); \
      pg8::EpiPl E{(bf16_t*)(ws + WS_PL), DM}; pg8::gemm_phase<pg8::EpiPl, pg8::StaticOrder, true, true>(lds, g, S, E); }
    if (blockIdx.x & 1) G1_PL();
    { pg8::Gemm g{XN, (const bf16_t*)(ws + WS_WIN), T, 1024, DM, DM}; pg8::StaticOrder S; S.init(T, 1024, G, (int)blockIdx.x);
      pg8::EpiBf16<0> E{PROJ, PP};
      pg8::gemm_phase<pg8::EpiBf16<0>, pg8::StaticOrder, true, true>(lds, g, S, E); }
    { pg8::Gemm g{XN, (const bf16_t*)(ws + WS_WIN) + (size_t)1024 * DM, T, 2048, DM, DM}; pg8::StaticOrder S; S.init(T, 2048, G, (int)blockIdx.x);
      pg8::EpiProjB E{PROJ, PP};
      pg8::gemm_phase<pg8::EpiProjB, pg8::StaticOrder, true, true>(lds, g, S, E); }
    if (!(blockIdx.x & 1)) G1_PL();
    xcd_barrier(bar);
    { pg8::Gemm g{PROJ, (const bf16_t*)(ws + WS_WUP), T, UPN, UPK, PP}; pg8::StaticOrder S; S.init(T, UPN, G, (int)blockIdx.x);
      pg8::EpiBf16<0> E{RAW, UPN};
      pg8::gemm_phase<pg8::EpiBf16<0>, pg8::StaticOrder, true, true>(lds, g, S, E); }
    { const int nunits = (T / 256) * (UPN / 256), idle0 = (nunits - G > 0 && nunits - G < G) ? nunits - G : 0;
      if ((int)blockIdx.x >= idle0) late_transposes(a, lds, ((int)blockIdx.x - idle0) * NWAVES + wave, (G - idle0) * NWAVES, wave, lane); }
    xcd_barrier(bar);
    phase4a(a, gw, NGW, lane);
    phase4b(a, lds, tid);
    xcd_barrier(bar);
    { const bf16_t* Qg = XN; const bf16_t* Kg = (const bf16_t*)(ws + WS_K); const bf16_t* Vtg = (const bf16_t*)(ws + WS_VT); bf16_t* Og = RAW;
      for (int c = blockIdx.x; c < 256; c += G) { const int bh = c & 7, pi = c >> 3;
          attn_unit(lds, Qg, Kg, Vtg, Og, bh, 63 - pi, tid, wave, lane);
          attn_unit(lds, Qg, Kg, Vtg, Og, bh, pi, tid, wave, lane); } }
    xcd_barrier(bar);
    phase6(a, gw, NGW, lane);
    xcd_barrier(bar);
    { pg8::Gemm g{XN, (const bf16_t*)(ws + WS_WO), T, DM, DM, DM}; pg8::StaticOrder S; S.init(T, DM, G, (int)blockIdx.x);
      pg8::EpiX1 E{a.x, a.out, (bf16_t*)(ws + WS_X1B), (float*)(ws + WS_ROWSQ), DM};
      pg8::gemm_phase<pg8::EpiX1, pg8::StaticOrder, true, true>(lds, g, S, E); }
    xcd_barrier(bar);
    { pg8::Gemm g{(const bf16_t*)(ws + WS_X1B), (const bf16_t*)(ws + WS_WPLG), T, DM, DM, DM}; pg8::StaticOrder S; S.init(T, DM, G, (int)blockIdx.x);
      pg8::EpiGateOut E{(const bf16_t*)(ws + WS_PL), (const bf16_t*)(ws + WS_X1B), a.out, (const float*)(ws + WS_ROWSQ), DM, EPS};
      pg8::gemm_phase<pg8::EpiGateOut, pg8::StaticOrder, true, true>(lds, g, S, E); }
    __syncthreads();
    { LAS unsigned* flag = (LAS unsigned*)(lds + 131072 + 16);
      if (tid == 0) flag[0] = (xb_add(&barw[XB_EXIT], 1u) == (unsigned)G - 1u) ? 1u : 0u;
      __syncthreads();
      if (flag[0]) { for (int i = tid; i < XCD_BAR_WORDS + 64; i += NTHREADS) __hip_atomic_store(&barw[i], 0u, __ATOMIC_RELAXED, __HIP_MEMORY_SCOPE_AGENT); } }
}

extern "C" void kernel_launch(void* const* d_in, const int* in_sizes, int n_in, void* d_out, int out_size, void* d_ws, size_t ws_size, hipStream_t stream) {
    static int grid = 0;
    if (grid == 0) {
        if (n_in != 18 || in_sizes[0] != T * DM || out_size != T * DM || ws_size < WS_END) { fprintf(stderr, "kernel_launch: unexpected shapes (n_in %d, in0 %d, out %d, ws %zu)\n", n_in, n_in > 0 ? in_sizes[0] : -1, out_size, ws_size); grid = -1; return; }
        int dev = 0, cus = 0, per_cu = 0;
        hipGetDevice(&dev); hipDeviceGetAttribute(&cus, hipDeviceAttributeMultiprocessorCount, dev);
        if (hipFuncSetAttribute((const void*)fwd_megakernel, hipFuncAttributeMaxDynamicSharedMemorySize, LDS_BYTES) != hipSuccess) { fprintf(stderr, "kernel_launch: hipFuncSetAttribute failed\n"); }
        if (hipOccupancyMaxActiveBlocksPerMultiprocessor(&per_cu, (const void*)fwd_megakernel, NTHREADS, LDS_BYTES) != hipSuccess || per_cu < 1) { fprintf(stderr, "kernel_launch: occupancy query says %d\n", per_cu); per_cu = 1; }
        (void)hipGetLastError();
        grid = cus * (per_cu > 1 ? 1 : per_cu);
        if (grid <= 0) grid = 256;
    }
    if (grid < 0) return;
    Args a{};
    a.x = (const float*)d_in[0]; a.p = (const float*)d_in[1]; a.pos = (const int*)d_in[2]; a.g_in = (const float*)d_in[3]; a.w_in = (const float*)d_in[4];
    a.g_cq = (const float*)d_in[5]; a.w_uq = (const float*)d_in[6]; a.g_ckv = (const float*)d_in[7]; a.w_ukv = (const float*)d_in[8];
    a.g_q = (const float*)d_in[9]; a.g_k = (const float*)d_in[10]; a.conv_w = (const float*)d_in[11]; a.g_oa = (const float*)d_in[12]; a.g_oc = (const float*)d_in[13];
    a.w_o = (const float*)d_in[14]; a.w_pl = (const float*)d_in[15]; a.w_plg = (const float*)d_in[16]; a.g_pl = (const float*)d_in[17];
    a.out = (float*)d_out; a.ws = (unsigned char*)d_ws;
    void* args[] = {&a};
    hipError_t e = hipLaunchCooperativeKernel((const void*)fwd_megakernel, dim3(grid), dim3(NTHREADS), args, LDS_BYTES, stream);
    if (e != hipSuccess) fprintf(stderr, "cooperative launch failed: %s (grid %d)\n", hipGetErrorString(e), grid);
}
```

```cpp
#include <hip/hip_runtime.h>
#include <hip/hip_cooperative_groups.h>
#include <cstdio>
#include <cstdint>
namespace cg = cooperative_groups;

typedef __bf16 bf16x2v_t __attribute__((ext_vector_type(2)));
typedef float f32x2_t __attribute__((ext_vector_type(2)));
__device__ __forceinline__ unsigned pk2(float a, float b) { f32x2_t v = {a, b}; bf16x2v_t r = __builtin_convertvector(v, bf16x2v_t); return __builtin_bit_cast(unsigned, r); }
__device__ __forceinline__ float bflo(unsigned u) { return __uint_as_float(u << 16); }
__device__ __forceinline__ float bfhi(unsigned u) { return __uint_as_float(u & 0xffff0000u); }
__device__ __forceinline__ float bf1(unsigned short u) { return __uint_as_float(((unsigned)u) << 16); }

namespace pg8 {
#define PG8_LAS __attribute__((address_space(3)))
typedef unsigned short bf16_t;
typedef short bf16x8 __attribute__((ext_vector_type(8)));
typedef float f32x4 __attribute__((ext_vector_type(4)));
typedef unsigned u32x4 __attribute__((ext_vector_type(4)));
constexpr int BM = 256, BK = 64, HALF = 128, HTB = HALF * BK * 2  , STAGE_BYTES = 8 * HTB, NXCD = 8, WGM = 8;

__host__ __device__ __forceinline__ int lds_byte(int r, int c) { const int st = (r >> 4) * 2 + (c >> 5), rr = r & 15, cc = c & 31, ob = rr * 64 + cc * 2; return st * 1024 + (ob ^ (((ob >> 9) & 1) << 5)); }
__host__ __device__ __forceinline__ void stage_rc(int b, int& R, int& C) { const int st = b / 1024, sb = b % 1024, swz = sb ^ (((sb >> 9) & 1) << 5); R = (st >> 1) * 16 + swz / 64; C = (st & 1) * 32 + (swz % 64) / 2; }
__host__ __device__ __forceinline__ int perm32(int rho) { const int n = rho >> 4, i = rho & 15; return 8 * (i >> 2) + 4 * n + (i & 3); }

struct Unit { int pm, pn; };
struct Gemm { const bf16_t* A; const bf16_t* Bt; int M, N, K, lda; };

struct StaticOrder {
    int nM, nN, nwg, G, c;
    __host__ __device__ void init(int M, int N, int G_, int c_) { nM = M / BM; nN = N / BM; nwg = nM * nN; G = G_; c = c_; }
    __host__ __device__ bool next(int i, Unit& u) const {
        const long L = (long)i * G + c; if (L >= nwg) return false;
        int wgid = (int)L; { const int q = nwg / NXCD, r = nwg % NXCD, xcd = wgid % NXCD, off = wgid / NXCD; wgid = (xcd < r ? xcd * (q + 1) : r * (q + 1) + (xcd - r) * q) + off; }
        const int nig = WGM * nN, gid = wgid / nig, fm = gid * WGM, gsz = (nM - fm) < WGM ? (nM - fm) : WGM;
        u.pm = fm + ((wgid % nig) % gsz); u.pn = (wgid % nig) / gsz; return true;
    }
    __device__ __forceinline__ void a_ready(const Unit&) const {}
    __device__ __forceinline__ void done(const Unit&) const {}
};


template <int ACT  > struct EpiBf16 {
    static constexpr bool PERM = true, AFTER_DRAIN = false;
    bf16_t* O; int ldc;
    __device__ __forceinline__ void operator()(const f32x4 (&acc)[2][2][4][2], const Unit& u, int wr, int wc, int fr, int fq) const {
        const int row0 = u.pm * BM + wr * 64 + fr; const int col0 = u.pn * BM + wc * 32 + 8 * fq;
#pragma unroll
        for (int ai = 0; ai < 2; ++ai)
#pragma unroll
            for (int m = 0; m < 4; ++m) { bf16_t* rowp = O + (size_t)(row0 + ai * HALF + m * 16) * ldc + col0;
#pragma unroll
                for (int bj = 0; bj < 2; ++bj) { f32x4 v0 = acc[ai][bj][m][0], v1 = acc[ai][bj][m][1];
                    if (ACT == 1) {
#pragma unroll
                        for (int e = 0; e < 4; ++e) { v0[e] = 1.f / (1.f + __expf(-v0[e])); v1[e] = 1.f / (1.f + __expf(-v1[e])); }
                    }
                    if (ACT == 2) {
                        const bool act = (u.pn >= 2);
#pragma unroll
                        for (int e = 0; e < 4; ++e) { const float s0 = v0[e] * __builtin_amdgcn_rcpf(1.f + __builtin_amdgcn_exp2f(-1.4426950408889634f * v0[e])), s1 = v1[e] * __builtin_amdgcn_rcpf(1.f + __builtin_amdgcn_exp2f(-1.4426950408889634f * v1[e]));
                            v0[e] = act ? s0 : v0[e]; v1[e] = act ? s1 : v1[e]; }
                    }
                    u32x4 w; w.x = pk2(v0[0], v0[1]); w.y = pk2(v0[2], v0[3]); w.z = pk2(v1[0], v1[1]); w.w = pk2(v1[2], v1[3]);
                    *(u32x4*)(rowp + bj * HALF) = w; } }
    }
};
struct EpiProjB {
    static constexpr bool PERM = false, AFTER_DRAIN = false;
    bf16_t* O; int ldc;
    __device__ __forceinline__ void operator()(const f32x4 (&acc)[2][2][4][2], const Unit& u, int wr, int wc, int fr, int fq) const {
        typedef unsigned u32x2 __attribute__((ext_vector_type(2)));
        const int row0 = u.pm * BM + wr * 64 + fr;
        const int ch0 = u.pn * 64 + 16 * wc + 4 * fq;
#pragma unroll
        for (int ai = 0; ai < 2; ++ai)
#pragma unroll
            for (int m = 0; m < 4; ++m) { bf16_t* rowp = O + (size_t)(row0 + ai * HALF + m * 16) * ldc + ch0;
                const f32x4 cb = acc[ai][0][m][0], zc = acc[ai][0][m][1], cc = acc[ai][1][m][0], cx = acc[ai][1][m][1]; f32x4 g, pr;
#pragma unroll
                for (int e = 0; e < 4; ++e) { g[e] = cb[e] * zc[e] * __builtin_amdgcn_rcpf(1.f + __builtin_amdgcn_exp2f(-1.4426950408889634f * zc[e])); pr[e] = cc[e] * cx[e]; }
                u32x2 w; w.x = pk2(g[0], g[1]); w.y = pk2(g[2], g[3]); *(u32x2*)(rowp + 1024) = w;
                w.x = pk2(pr[0], pr[1]); w.y = pk2(pr[2], pr[3]); *(u32x2*)(rowp + 1536) = w; }
    }
};
struct EpiX1 {
    static constexpr bool PERM = true, AFTER_DRAIN = false;
    const float* base; float* out; bf16_t* xb; float* rowsq; int ldc;
    __device__ __forceinline__ void operator()(const f32x4 (&acc)[2][2][4][2], const Unit& u, int wr, int wc, int fr, int fq) const {
        const int row0 = u.pm * BM + wr * 64 + fr; const int col0 = u.pn * BM + wc * 32 + 8 * fq;
#pragma unroll
        for (int ai = 0; ai < 2; ++ai)
#pragma unroll
            for (int m = 0; m < 4; ++m) { const int row = row0 + ai * HALF + m * 16; const size_t off = (size_t)row * ldc + col0; float s = 0.f;
#pragma unroll
                for (int bj = 0; bj < 2; ++bj) { const size_t o2 = off + bj * HALF;
                    const f32x4 v0 = *(const f32x4*)(base + o2) + acc[ai][bj][m][0], v1 = *(const f32x4*)(base + o2 + 4) + acc[ai][bj][m][1];
                    u32x4 w; w.x = pk2(v0[0], v0[1]); w.y = pk2(v0[2], v0[3]); w.z = pk2(v1[0], v1[1]); w.w = pk2(v1[2], v1[3]); *(u32x4*)(xb + o2) = w;
                    s += ((v0[0] * v0[0] + v0[1] * v0[1]) + (v0[2] * v0[2] + v0[3] * v0[3])) + ((v1[0] * v1[0] + v1[1] * v1[1]) + (v1[2] * v1[2] + v1[3] * v1[3])); }
                s += __shfl_xor(s, 16); s += __shfl_xor(s, 32);
                if (fq == 0) atomicAdd(rowsq + row, s);
                if (m & 1) asm volatile("" ::: "memory"); }
    }
};
struct EpiPl {
    static constexpr bool PERM = true, AFTER_DRAIN = false;
    bf16_t* pl; int ldc;
    __device__ __forceinline__ void operator()(const f32x4 (&acc)[2][2][4][2], const Unit& u, int wr, int wc, int fr, int fq) const {
        const int row0 = u.pm * BM + wr * 64 + fr; const int col0 = u.pn * BM + wc * 32 + 8 * fq;
#pragma unroll
        for (int ai = 0; ai < 2; ++ai)
#pragma unroll
            for (int m = 0; m < 4; ++m) { const size_t off = (size_t)(row0 + ai * HALF + m * 16) * ldc + col0;
#pragma unroll
                for (int bj = 0; bj < 2; ++bj) { const f32x4 v0 = acc[ai][bj][m][0], v1 = acc[ai][bj][m][1];
                    u32x4 w; w.x = pk2(v0[0], v0[1]); w.y = pk2(v0[2], v0[3]); w.z = pk2(v1[0], v1[1]); w.w = pk2(v1[2], v1[3]); *(u32x4*)(pl + off + bj * HALF) = w; } }
    }
};
struct EpiGateOut {
    static constexpr bool PERM = true, AFTER_DRAIN = false;
    const bf16_t* pl; const bf16_t* xb; float* out; const float* rowsq; int ldc; float eps;
    __device__ __forceinline__ void operator()(const f32x4 (&acc)[2][2][4][2], const Unit& u, int wr, int wc, int fr, int fq) const {
        const int row0 = u.pm * BM + wr * 64 + fr; const int col0 = u.pn * BM + wc * 32 + 8 * fq;
#pragma unroll
        for (int ai = 0; ai < 2; ++ai)
#pragma unroll
            for (int m = 0; m < 4; ++m) { const int row = row0 + ai * HALF + m * 16; const size_t off = (size_t)row * ldc + col0;
                const float nrl = -1.4426950408889634f * __builtin_amdgcn_rsqf(__hip_atomic_load(rowsq + row, __ATOMIC_RELAXED, __HIP_MEMORY_SCOPE_AGENT) * (1.f / (float)ldc) + eps);
#pragma unroll
                for (int bj = 0; bj < 2; ++bj) { const size_t o2 = off + bj * HALF; const u32x4 xw = *(const u32x4*)(xb + o2), g = *(const u32x4*)(pl + o2);
                    f32x4 b0, b1, p0, p1;
                    b0[0] = __uint_as_float(xw.x << 16); b0[1] = __uint_as_float(xw.x & 0xffff0000u); b0[2] = __uint_as_float(xw.y << 16); b0[3] = __uint_as_float(xw.y & 0xffff0000u);
                    b1[0] = __uint_as_float(xw.z << 16); b1[1] = __uint_as_float(xw.z & 0xffff0000u); b1[2] = __uint_as_float(xw.w << 16); b1[3] = __uint_as_float(xw.w & 0xffff0000u);
                    p0[0] = __uint_as_float(g.x << 16); p0[1] = __uint_as_float(g.x & 0xffff0000u); p0[2] = __uint_as_float(g.y << 16); p0[3] = __uint_as_float(g.y & 0xffff0000u);
                    p1[0] = __uint_as_float(g.z << 16); p1[1] = __uint_as_float(g.z & 0xffff0000u); p1[2] = __uint_as_float(g.w << 16); p1[3] = __uint_as_float(g.w & 0xffff0000u);
                    f32x4 s0, s1;
#pragma unroll
                    for (int e = 0; e < 4; ++e) { s0[e] = __builtin_amdgcn_rcpf(1.f + __builtin_amdgcn_exp2f(nrl * acc[ai][bj][m][0][e])); s1[e] = __builtin_amdgcn_rcpf(1.f + __builtin_amdgcn_exp2f(nrl * acc[ai][bj][m][1][e])); }
                    *(f32x4*)(out + o2) = b0 + s0 * p0; *(f32x4*)(out + o2 + 4) = b1 + s1 * p1; }
                if (m & 1) asm volatile("" ::: "memory"); }
    }
};

template <class Epi, class Sched, bool ALIGN_EPI = false, bool SP2 = false>
__device__ __forceinline__ void gemm_phase(PG8_LAS unsigned char* lds, const Gemm g, const Sched& S, const Epi& E) {
    int tid_ = threadIdx.x; asm volatile("" : "+v"(tid_));
    const int tid = tid_, wid = __builtin_amdgcn_readfirstlane(tid >> 6), lane = tid & 63, wr = wid >> 2, wc = wid & 3, fr = lane & 15, fq = lane >> 4;
    const int K = g.K, nt = K / BK;
    unsigned voffA[2], voffB[2];
#pragma unroll
    for (int i = 0; i < 2; ++i) { int R, C; stage_rc(tid * 16 + i * 8192, R, C); const int Rb = Epi::PERM ? ((R & ~31) + perm32(R & 31)) : R;
        voffA[i] = (unsigned)(R * g.lda + C) * 2u; voffB[i] = (unsigned)(Rb * K + C) * 2u; }
    const size_t kstep = (size_t)(BK * 2);
    const size_t hstepB = (size_t)HALF * K * 2, hstepA = (size_t)HALF * g.lda * 2;
    const size_t tstepB = 2 * hstepB, tstepA = 2 * hstepA;
    const unsigned ldsw = (unsigned)wid * 1024u;
    const int aoff = lds_byte(wr * 64 + fr, fq * 8), boff = lds_byte(wc * 32 + fr, fq * 8);
#define PG8_SA(b, h) (((b) * 2 + (h)) * HTB)
#define PG8_SB(b, h) ((4 + (b) * 2 + (h)) * HTB)
#define PG8_STAGE(bufoff, gbase, voff) do { _Pragma("unroll") for (int _i = 0; _i < 2; ++_i) \
        __builtin_amdgcn_global_load_lds((const unsigned*)((const char*)(gbase) + (voff)[_i]), (PG8_LAS unsigned*)(lds + (bufoff) + ldsw + _i * 8192), 16, 0, 0); } while (0)
#define PG8_LDA(dst, b, h) do { _Pragma("unroll") for (int m = 0; m < 4; ++m) _Pragma("unroll") for (int k = 0; k < 2; ++k) dst[m][k] = *(const PG8_LAS bf16x8*)(lds + PG8_SA(b, h) + aoff + m * 2048 + k * 1024); } while (0)
#define PG8_LDB(dst, b, h) do { _Pragma("unroll") for (int n = 0; n < 2; ++n) _Pragma("unroll") for (int k = 0; k < 2; ++k) dst[n][k] = *(const PG8_LAS bf16x8*)(lds + PG8_SB(b, h) + boff + n * 2048 + k * 1024); } while (0)
#define PG8_MMA(ai, bj, At, Bt) do { __builtin_amdgcn_s_setprio(1); _Pragma("unroll") for (int m = 0; m < 4; ++m) _Pragma("unroll") for (int n = 0; n < 2; ++n) _Pragma("unroll") for (int k = 0; k < 2; ++k) \
        acc[ai][bj][m][n] = __builtin_amdgcn_mfma_f32_16x16x32_bf16(Bt[n][k], At[m][k], acc[ai][bj][m][n], 0, 0, 0); __builtin_amdgcn_s_setprio(0); } while (0)
#define PG8_WAIT_V(n) asm volatile("s_waitcnt vmcnt(" #n ")" ::: "memory")
#define PG8_WAIT_L(n) asm volatile("s_waitcnt lgkmcnt(" #n ")" ::: "memory")
#define PG8_BAR __builtin_amdgcn_s_barrier()
#define PG8_SCHED __builtin_amdgcn_sched_barrier(0)
    Unit cur, nxt; int ui = 0;
    if (!S.next(0, cur)) return;
    f32x4 acc[2][2][4][2];
#pragma unroll
    for (int a = 0; a < 2; ++a)
#pragma unroll
        for (int b = 0; b < 2; ++b)
#pragma unroll
            for (int m = 0; m < 4; ++m)
#pragma unroll
                for (int n = 0; n < 2; ++n) acc[a][b][m][n] = (f32x4){0.f, 0.f, 0.f, 0.f};
    bf16x8 At[4][2], B0[2][2], B1[2][2];
    const char* cA = (const char*)g.A + (size_t)cur.pm * tstepA; const char* cB = (const char*)g.Bt + (size_t)cur.pn * tstepB;
    S.a_ready(cur);
    if constexpr (SP2) {
        PG8_STAGE(PG8_SB(0, 0), cB, voffB); PG8_STAGE(PG8_SB(0, 1), cB + hstepB, voffB); PG8_STAGE(PG8_SA(0, 0), cA, voffA); PG8_STAGE(PG8_SA(0, 1), cA + hstepA, voffA);
        if (wr == 1) PG8_BAR;
        PG8_WAIT_V(2); PG8_BAR;
        PG8_STAGE(PG8_SB(1, 0), cB + kstep, voffB); PG8_STAGE(PG8_SA(1, 0), cA + kstep, voffA); PG8_STAGE(PG8_SB(1, 1), cB + hstepB + kstep, voffB);
        PG8_WAIT_V(6); PG8_BAR;
    } else {
        PG8_STAGE(PG8_SB(0, 0), cB, voffB); PG8_STAGE(PG8_SA(0, 0), cA, voffA); PG8_STAGE(PG8_SB(0, 1), cB + hstepB, voffB); PG8_STAGE(PG8_SA(0, 1), cA + hstepA, voffA);
        if (wr == 1) PG8_BAR;
        PG8_WAIT_V(4); PG8_BAR;
        PG8_STAGE(PG8_SB(1, 0), cB + kstep, voffB); PG8_STAGE(PG8_SA(1, 0), cA + kstep, voffA); PG8_STAGE(PG8_SB(1, 1), cB + hstepB + kstep, voffB);
        PG8_WAIT_V(6); PG8_BAR;
    }
    for (;;) {
        const bool has_next = S.next(ui + 1, nxt);
        const char* nA = has_next ? (const char*)g.A + (size_t)nxt.pm * tstepA : cA; const char* nB = has_next ? (const char*)g.Bt + (size_t)nxt.pn * tstepB : cB;
        for (int t = 0; t < nt; t += 2) {
            const bool last = (t == nt - 2);
            const char* a1 = cA + (size_t)(t + 1) * kstep;
            const char* a2 = last ? nA : cA + (size_t)(t + 2) * kstep; const char* b2 = last ? nB : cB + (size_t)(t + 2) * kstep;
            const char* a3 = a2 + kstep; const char* b3 = b2 + kstep;
            if (last && has_next) S.a_ready(nxt);
            if constexpr (SP2) {
            PG8_LDB(B0, 0, 0); PG8_LDB(B1, 0, 1); PG8_SCHED; PG8_LDA(At, 0, 0); PG8_STAGE(PG8_SA(1, 1), a1 + hstepA, voffA);
            PG8_WAIT_V(8); PG8_WAIT_L(0); PG8_BAR; PG8_MMA(0, 0, At, B0); PG8_MMA(0, 1, At, B1); PG8_BAR; PG8_SCHED;
            PG8_LDA(At, 0, 1); PG8_STAGE(PG8_SB(0, 0), b2, voffB); PG8_STAGE(PG8_SB(0, 1), b2 + hstepB, voffB); PG8_STAGE(PG8_SA(0, 0), a2, voffA);
            PG8_WAIT_V(8); PG8_WAIT_L(0); PG8_BAR; PG8_MMA(1, 0, At, B0); PG8_MMA(1, 1, At, B1); PG8_BAR; PG8_SCHED;
            PG8_LDB(B0, 1, 0); PG8_LDB(B1, 1, 1); PG8_SCHED; PG8_LDA(At, 1, 0); PG8_STAGE(PG8_SA(0, 1), a2 + hstepA, voffA);
            PG8_WAIT_V(8); PG8_WAIT_L(0); PG8_BAR; PG8_MMA(0, 0, At, B0); PG8_MMA(0, 1, At, B1); PG8_BAR; PG8_SCHED;
            PG8_LDA(At, 1, 1); PG8_STAGE(PG8_SB(1, 0), b3, voffB); PG8_STAGE(PG8_SB(1, 1), b3 + hstepB, voffB); PG8_STAGE(PG8_SA(1, 0), a3, voffA);
            PG8_WAIT_V(8); PG8_WAIT_L(0); PG8_BAR; PG8_MMA(1, 0, At, B0); PG8_MMA(1, 1, At, B1); PG8_BAR; PG8_SCHED;
            } else {
            PG8_LDB(B0, 0, 0); PG8_SCHED; PG8_LDA(At, 0, 0); PG8_STAGE(PG8_SA(1, 1), a1 + hstepA, voffA);
            PG8_WAIT_L(8); PG8_BAR; PG8_WAIT_L(0); PG8_MMA(0, 0, At, B0); PG8_BAR; PG8_SCHED;
            PG8_LDB(B1, 0, 1); PG8_STAGE(PG8_SB(0, 0), b2, voffB);
            PG8_BAR; PG8_WAIT_L(0); PG8_MMA(0, 1, At, B1); PG8_BAR;
            PG8_LDA(At, 0, 1); PG8_STAGE(PG8_SA(0, 0), a2, voffA);
            PG8_BAR; PG8_WAIT_L(0); PG8_MMA(1, 0, At, B0); PG8_BAR; PG8_SCHED;
            PG8_STAGE(PG8_SB(0, 1), b2 + hstepB, voffB);
            PG8_WAIT_V(6); PG8_BAR; PG8_MMA(1, 1, At, B1); PG8_BAR;
            PG8_LDB(B0, 1, 0); PG8_SCHED; PG8_LDA(At, 1, 0); PG8_STAGE(PG8_SA(0, 1), a2 + hstepA, voffA);
            PG8_WAIT_L(8); PG8_BAR; PG8_WAIT_L(0); PG8_MMA(0, 0, At, B0); PG8_BAR; PG8_SCHED;
            PG8_LDB(B1, 1, 1); PG8_STAGE(PG8_SB(1, 0), b3, voffB);
            PG8_BAR; PG8_WAIT_L(0); PG8_MMA(0, 1, At, B1); PG8_BAR;
            PG8_LDA(At, 1, 1); PG8_STAGE(PG8_SA(1, 0), a3, voffA);
            PG8_BAR; PG8_WAIT_L(0); PG8_MMA(1, 0, At, B0); PG8_BAR; PG8_SCHED;
            PG8_STAGE(PG8_SB(1, 1), b3 + hstepB, voffB);
            PG8_WAIT_V(6); PG8_BAR; PG8_MMA(1, 1, At, B1); PG8_BAR;
            }
        }
        if constexpr (ALIGN_EPI) { if (wr == 0) PG8_BAR; }
        if constexpr (!Epi::AFTER_DRAIN) { int fr_ = fr, fq_ = fq; asm volatile("" : "+v"(fr_), "+v"(fq_));
            E(acc, cur, wr, wc, fr_, fq_); S.done(cur); }
        if (!has_next) break;
#pragma unroll
        for (int a = 0; a < 2; ++a)
#pragma unroll
            for (int b = 0; b < 2; ++b)
#pragma unroll
                for (int m = 0; m < 4; ++m)
#pragma unroll
                    for (int n = 0; n < 2; ++n) acc[a][b][m][n] = (f32x4){0.f, 0.f, 0.f, 0.f};
        cur = nxt; cA = nA; cB = nB; ++ui;
        if constexpr (ALIGN_EPI) { if (wr == 1) PG8_BAR; }
    }
    PG8_WAIT_V(0);
    if constexpr (!ALIGN_EPI) { if (wr == 0) PG8_BAR; }
    PG8_BAR;
    if constexpr (Epi::AFTER_DRAIN) { E.fused(acc, cur, wr, wc, fr, fq, lds, wid, lane); S.done(cur); }
#undef PG8_SA
#undef PG8_SB
#undef PG8_STAGE
#undef PG8_LDA
#undef PG8_LDB
#undef PG8_MMA
#undef PG8_WAIT_V
#undef PG8_WAIT_L
#undef PG8_BAR
#undef PG8_SCHED
}
}

constexpr int BATCH = 2, SEQ = 8192, DM = 1024, T = BATCH * SEQ;
constexpr int PLE = 256, NH = 4, NOPE = 128, ROPE = 64, VD = 128, QKD = 192, QLORA = 256, KVLORA = 128, AW = 512, CW = 512;
constexpr int INTOT = 3008, INPAD = 3072;
constexpr int PP = 2048;
constexpr int C_CQ = 0, C_CKV = 256, C_KPE = 384, C_ZA = 512, C_G = 1024, C_PR = 1536;
constexpr int UPK = 384, UPN = 1792;
constexpr float EPS = 1e-6f;
constexpr int NWAVES = 8, NTHREADS = 512;

constexpr size_t MiB = 1u << 20;
constexpr size_t WS_WIN = 0;
constexpr size_t WS_WUP = 6 * MiB;
constexpr size_t WS_WO = 8 * MiB;
constexpr size_t WS_WPLG = 10 * MiB;
constexpr size_t WS_WPL = 12 * MiB;
constexpr size_t WS_XN = 16 * MiB;
constexpr size_t WS_PB = 48 * MiB;
constexpr size_t WS_PROJ = 56 * MiB;
constexpr size_t WS_QKVRAW = 152 * MiB;
constexpr size_t WS_K = 208 * MiB;
constexpr size_t WS_VT = 232 * MiB;
constexpr size_t WS_END = 248 * MiB;
constexpr size_t WS_ROWSQ = 14 * MiB;
constexpr size_t WS_X1B = WS_PROJ;
constexpr size_t WS_PL = WS_PROJ + 64 * MiB;

#define LAS __attribute__((address_space(3)))
typedef unsigned short bf16_t;
typedef short bf16x8 __attribute__((ext_vector_type(8)));
typedef float f32x4 __attribute__((ext_vector_type(4)));
typedef float f32x16 __attribute__((ext_vector_type(16)));
typedef unsigned u32x4 __attribute__((ext_vector_type(4)));
typedef unsigned u32x2 __attribute__((ext_vector_type(2)));

struct Args {
    const float* x; const float* p; const int* pos; const float* g_in; const float* w_in; const float* g_cq; const float* w_uq; const float* g_ckv; const float* w_ukv;
    const float* g_q; const float* g_k; const float* conv_w; const float* g_oa; const float* g_oc; const float* w_o; const float* w_pl; const float* w_plg; const float* g_pl;
    float* out; unsigned char* ws; int never; int pad;
};

__device__ __forceinline__ float wave_sum(float v) {
#pragma unroll
    for (int o = 1; o < 64; o <<= 1) v += __shfl_xor(v, o);
    return v;
}
__device__ __forceinline__ float max_xor32(float x) { const u32x2 r = __builtin_amdgcn_permlane32_swap(__float_as_uint(x), __float_as_uint(x), false, false); return fmaxf(__uint_as_float(r.x), __uint_as_float(r.y)); }
__device__ __forceinline__ float silu_f(float z) { return z / (1.f + __expf(-z)); }

__device__ __forceinline__ int win_row(int n) {
    if (n < 448) return n;
    if (n < 960) return n + 64;
    const int t = n - 960, q = t >> 9, ch = t & 511, qn = (q == 0) ? 0 : (q == 1) ? 2 : (q == 2) ? 3 : 1, cg = ch >> 6, ci = ch & 63;
    return 1024 + 256 * cg + 128 * (qn >> 1) + 32 * (ci >> 4) + 16 * (qn & 1) + (ci & 15);
}
template <bool WINMAP = false>
__device__ __forceinline__ void p0_transpose_item(const float* W, int N, bf16_t* WT, int ldt, int row_off, int col_off, LAS float* scr, int item, int lane, const float* gk = nullptr) {
    const int nblk = N / 32, kb = item / nblk, nb = item % nblk, k0 = 64 * kb, n0 = 32 * nb;
    { f32x4 v[8];
#pragma unroll
      for (int i = 0; i < 8; ++i) v[i] = *(const f32x4*)(W + (size_t)(k0 + 8 * i + (lane >> 3)) * N + n0 + 4 * (lane & 7));
#pragma unroll
      for (int i = 0; i < 8; ++i) { const int kk = 8 * i + (lane >> 3); const float gg = gk ? gk[k0 + kk] : 1.f; LAS float* d = scr + kk * 33 + 4 * (lane & 7);
          d[0] = v[i][0] * gg; d[1] = v[i][1] * gg; d[2] = v[i][2] * gg; d[3] = v[i][3] * gg; } }
    asm volatile("s_waitcnt lgkmcnt(0)" ::: "memory");
    const int c = lane & 7;
#pragma unroll
    for (int j = 0; j < 4; ++j) { const int n = (lane >> 3) + 8 * j; const LAS float* s = scr + (8 * c) * 33 + n;
        u32x4 o; o.x = pk2(s[0 * 33], s[1 * 33]); o.y = pk2(s[2 * 33], s[3 * 33]); o.z = pk2(s[4 * 33], s[5 * 33]); o.w = pk2(s[6 * 33], s[7 * 33]);
        *(u32x4*)(WT + (size_t)(WINMAP ? win_row(n0 + n) : row_off + n0 + n) * ldt + col_off + k0 + 8 * c) = o; }
    asm volatile("s_waitcnt lgkmcnt(0)" ::: "memory");
}

__device__ __forceinline__ void phase0(const Args& a, LAS unsigned char* lds, int gw_, int NGW, int wave, int lane_) {
    int lane = lane_; asm volatile("" : "+v"(lane));
    const int gw = blockIdx.x * NWAVES + wave;
    unsigned char* ws = a.ws;
    bf16_t* WinT = (bf16_t*)(ws + WS_WIN); bf16_t* WupT = (bf16_t*)(ws + WS_WUP); bf16_t* WoT = (bf16_t*)(ws + WS_WO); bf16_t* WplgT = (bf16_t*)(ws + WS_WPLG); bf16_t* WplT = (bf16_t*)(ws + WS_WPL);
    LAS float* scr = (LAS float*)(lds + wave * 16384);
    constexpr int I_IN = (DM / 64) * (INTOT / 32), I_UQ = (QLORA / 64) * (768 / 32), I_UKV = (KVLORA / 64) * (1024 / 32), I_O = (DM / 64) * (DM / 32), I_PLG = I_O, I_PL = (PLE / 64) * (DM / 32);
    constexpr int NITEMS = I_IN + I_UQ + I_UKV + I_PL;
    (void)I_O; (void)I_PLG; (void)WoT; (void)WplgT;
    for (int it = gw; it < NITEMS; it += NGW) {
        int r = it;
        if (r < I_IN) { p0_transpose_item<true>(a.w_in, INTOT, WinT, DM, 0, 0, scr, r, lane); continue; } r -= I_IN;
        if (r < I_UQ) { p0_transpose_item(a.w_uq, 768, WupT, UPK, 0, 0, scr, r, lane, a.g_cq); continue; } r -= I_UQ;
        if (r < I_UKV) { p0_transpose_item(a.w_ukv, 1024, WupT, UPK, 768, 256, scr, r, lane, a.g_ckv); continue; } r -= I_UKV;
        p0_transpose_item(a.w_pl, DM, WplT, PLE, 0, 0, scr, r, lane);
    }
    const int gt = gw * 64 + lane, NGT = NGW * 64;
    for (int c = gt; c < (INPAD - INTOT) * DM / 8; c += NGT) *(u32x4*)(WinT + (size_t)448 * DM + (size_t)c * 8) = (u32x4){0u, 0u, 0u, 0u};
    for (int c = gt; c < UPN * (UPK / 8); c += NGT) { const int row = c / (UPK / 8), col = (c % (UPK / 8)) * 8; const bool diag = (row < 768) ? (col < 256) : (col >= 256);
        if (!diag) *(u32x4*)(WupT + (size_t)row * UPK + col) = (u32x4){0u, 0u, 0u, 0u}; }
    { float* rowsq = (float*)(ws + WS_ROWSQ); for (int c = gt; c < T; c += NGT) rowsq[c] = 0.f; }
    { bf16_t* PB = (bf16_t*)(ws + WS_PB);
      for (int c = gt; c < T * PLE / 8; c += NGT) { const f32x4 v0 = *(const f32x4*)(a.p + (size_t)c * 8), v1 = *(const f32x4*)(a.p + (size_t)c * 8 + 4);
          u32x4 o; o.x = pk2(v0[0], v0[1]); o.y = pk2(v0[2], v0[3]); o.z = pk2(v1[0], v1[1]); o.w = pk2(v1[2], v1[3]); *(u32x4*)(PB + (size_t)c * 8) = o; } }
    { bf16_t* XN = (bf16_t*)(ws + WS_XN);
      f32x4 g[4];
#pragma unroll
      for (int j = 0; j < 4; ++j) g[j] = *(const f32x4*)(a.g_in + 4 * lane + 256 * j);
      for (int m = gw; m < T; m += NGW) { const float* xr = a.x + (size_t)m * DM + 4 * lane; f32x4 v[4]; float s = 0.f;
#pragma unroll
          for (int j = 0; j < 4; ++j) { v[j] = *(const f32x4*)(xr + 256 * j); s += (v[j][0] * v[j][0] + v[j][1] * v[j][1]) + (v[j][2] * v[j][2] + v[j][3] * v[j][3]); }
          const float rstd = rsqrtf(wave_sum(s) * (1.f / DM) + EPS);
#pragma unroll
          for (int j = 0; j < 4; ++j) { const f32x4 o = v[j] * rstd * g[j]; u32x2 w; w.x = pk2(o[0], o[1]); w.y = pk2(o[2], o[3]); *(u32x2*)(XN + (size_t)m * DM + 4 * lane + 256 * j) = w; } } }
}

__device__ __forceinline__ void late_transposes(const Args& a, LAS unsigned char* lds, int rank_wave, int n_waves, int wave, int lane_) {
    int lane = lane_; asm volatile("" : "+v"(lane));
    bf16_t* WoT = (bf16_t*)(a.ws + WS_WO); bf16_t* WplgT = (bf16_t*)(a.ws + WS_WPLG);
    LAS float* scr = (LAS float*)(lds + wave * 16384);
    constexpr int I_O = (DM / 64) * (DM / 32);
    for (int it = rank_wave; it < 2 * I_O; it += n_waves) {
        if (it < I_O) p0_transpose_item(a.w_o, DM, WoT, DM, 0, 0, scr, it, lane);
        else p0_transpose_item(a.w_plg, DM, WplgT, DM, 0, 0, scr, it - I_O, lane, a.g_pl);
    }
}
struct TokIn { unsigned short q[4][3]; unsigned short k[4][2]; unsigned short kpe; u32x2 cq; unsigned ckv; int pos; };
__device__ __forceinline__ void p4_load(TokIn& t, const bf16_t* PROJ, const bf16_t* RAW, const int* pos, int m, int lane) {
    const bf16_t* pr = PROJ + (size_t)m * PP; const bf16_t* rr = RAW + (size_t)m * UPN;
#pragma unroll
    for (int h = 0; h < NH; ++h) {
#pragma unroll
        for (int i = 0; i < 3; ++i) t.q[h][i] = rr[h * QKD + lane + 64 * i];
#pragma unroll
        for (int i = 0; i < 2; ++i) t.k[h][i] = rr[768 + h * 256 + lane + 64 * i];
    }
    t.kpe = pr[C_KPE + lane]; t.cq = *(const u32x2*)(pr + C_CQ + 4 * lane); t.ckv = *(const unsigned*)(pr + C_CKV + 2 * lane); t.pos = pos[m];
}
__device__ __forceinline__ unsigned short bf16r(float v) { return (unsigned short)(pk2(v, 0.f) & 0xffffu); }
__device__ __forceinline__ void phase4a(const Args& a, int gw, int NGW, int lane_) {
    int lane = lane_; asm volatile("" : "+v"(lane));
    const bf16_t* PROJ = (const bf16_t*)(a.ws + WS_PROJ); const bf16_t* RAW = (const bf16_t*)(a.ws + WS_QKVRAW);
    bf16_t* Q = (bf16_t*)(a.ws + WS_XN); bf16_t* K = (bf16_t*)(a.ws + WS_K);
    const float gq0 = a.g_q[lane], gq1 = a.g_q[lane + 64], gq2 = a.g_q[lane + 128];
    const float gk0 = a.g_k[lane], gk1 = a.g_k[lane + 64], gk2 = a.g_k[lane + 128];
    const int fi = lane & 31; const float inv_freq = 1.0f / powf(10000.0f, (float)(2 * fi) / 64.0f);
    const float qscale = 0.07216878364870322f * 1.4426950408889634f;
    const float sgn = (lane < 32) ? -1.f : 1.f;
    TokIn cur, nxt; int m = gw;
    if (m < T) p4_load(cur, PROJ, RAW, a.pos, m, lane);
    for (; m < T; m += NGW) {
        const int mn = m + NGW; if (mn < T) p4_load(nxt, PROJ, RAW, a.pos, mn, lane);
        const int b = m / SEQ, s = m % SEQ;
        float qv[4][3], kv[4][2]; const float kpe = bf1(cur.kpe);
        float red[11];
        { const float c0 = bflo(cur.cq.x), c1 = bfhi(cur.cq.x), c2 = bflo(cur.cq.y), c3 = bfhi(cur.cq.y), d0 = bflo(cur.ckv), d1 = bfhi(cur.ckv);
          red[0] = (c0 * c0 + c1 * c1) + (c2 * c2 + c3 * c3); red[1] = d0 * d0 + d1 * d1; red[2] = kpe * kpe; }
#pragma unroll
        for (int h = 0; h < NH; ++h) { qv[h][0] = bf1(cur.q[h][0]); qv[h][1] = bf1(cur.q[h][1]); qv[h][2] = bf1(cur.q[h][2]); kv[h][0] = bf1(cur.k[h][0]); kv[h][1] = bf1(cur.k[h][1]);
            red[3 + h] = qv[h][0] * qv[h][0] + qv[h][1] * qv[h][1] + qv[h][2] * qv[h][2]; red[7 + h] = kv[h][0] * kv[h][0] + kv[h][1] * kv[h][1]; }
#pragma unroll
        for (int o = 1; o < 64; o <<= 1) {
#pragma unroll
            for (int e = 0; e < 11; ++e) red[e] += __shfl_xor(red[e], o);
        }
        const float rq = rsqrtf(red[0] * (1.f / QLORA) + EPS), rkv = rsqrtf(red[1] * (1.f / KVLORA) + EPS);
        const float ang = (float)cur.pos * inv_freq; float sn, cs; sincosf(ang, &sn, &cs);
        const float kp = kpe * gk2; const float kpo = __shfl_xor(kp, 32); const float kprope = kp * cs + sgn * kpo * sn;
#pragma unroll
        for (int h = 0; h < NH; ++h) {
            const float rs = rsqrtf(rq * rq * red[3 + h] * (1.f / QKD) + EPS) * rq * qscale;
            const float v0 = qv[h][0] * rs * gq0, v1 = qv[h][1] * rs * gq1, v2 = qv[h][2] * rs * gq2;
            const float o2 = __shfl_xor(v2, 32); const float r2 = v2 * cs + sgn * o2 * sn;
            bf16_t* qo = Q + ((size_t)(b * NH + h) * SEQ + s) * QKD;
            qo[lane] = bf16r(v0); qo[lane + 64] = bf16r(v1); qo[lane + 128] = bf16r(r2);
            const float rk = rsqrtf((rkv * rkv * red[7 + h] + red[2]) * (1.f / QKD) + EPS);
            bf16_t* ko = K + ((size_t)(b * NH + h) * SEQ + s) * QKD;
            ko[lane] = bf16r(kv[h][0] * rkv * rk * gk0); ko[lane + 64] = bf16r(kv[h][1] * rkv * rk * gk1); ko[lane + 128] = bf16r(kprope * rk);
        }
        cur = nxt;
    }
}
__device__ __forceinline__ void phase4b(const Args& a, LAS unsigned char* lds, int tid_) {
    int tid = tid_; asm volatile("" : "+v"(tid));
    const bf16_t* PROJ = (const bf16_t*)(a.ws + WS_PROJ); const bf16_t* RAW = (const bf16_t*)(a.ws + WS_QKVRAW); bf16_t* VT = (bf16_t*)(a.ws + WS_VT);
    constexpr int PITCH = 1040;
    LAS float* rkl = (LAS float*)(lds + 64 * PITCH);
    const int lane = tid & 63, wave = tid >> 6;
    for (int tile = blockIdx.x; tile < T / 64; tile += gridDim.x) {
        const int row0 = tile * 64;
        { float red[8];
#pragma unroll
          for (int e = 0; e < 8; ++e) { const unsigned c = *(const unsigned*)(PROJ + (size_t)(row0 + wave * 8 + e) * PP + C_CKV + 2 * lane); const float d0 = bflo(c), d1 = bfhi(c); red[e] = d0 * d0 + d1 * d1; }
#pragma unroll
          for (int o = 1; o < 64; o <<= 1) {
#pragma unroll
              for (int e = 0; e < 8; ++e) red[e] += __shfl_xor(red[e], o);
          }
#pragma unroll
          for (int e = 0; e < 8; ++e) if (lane == e) rkl[wave * 8 + e] = rsqrtf(red[e] * (1.f / KVLORA) + EPS); }
#pragma unroll
        for (int i = 0; i < 8; ++i) { const int c = tid + 512 * i, tok = c >> 6, rem = c & 63, h = rem >> 4, part = rem & 15;
            const u32x4 v = *(const u32x4*)(RAW + (size_t)(row0 + tok) * UPN + 768 + h * 256 + 128 + part * 8);
            *(LAS u32x4*)(lds + tok * PITCH + (h * 128 + part * 8) * 2) = v; }
        __syncthreads();
        const int b = row0 / SEQ, s0 = row0 % SEQ, ch = tid & 7;
        int key[8];
#pragma unroll
        for (int e = 0; e < 8; ++e) { const int p = ch * 8 + e, q = p & 15; key[e] = 16 * (p >> 4) + 8 * ((q & 7) >> 2) + 4 * (q >> 3) + (q & 3); }
        float rk[8];
#pragma unroll
        for (int e = 0; e < 8; ++e) rk[e] = rkl[key[e]];
#pragma unroll
        for (int i = 0; i < 8; ++i) {
            const int row = (tid >> 3) + 64 * i, h = row >> 7, d = row & 127;
            unsigned w[4];
#pragma unroll
            for (int e = 0; e < 4; ++e) {
                const float lo = bf1(*(const LAS unsigned short*)(lds + key[2 * e] * PITCH + row * 2)) * rk[2 * e], hi = bf1(*(const LAS unsigned short*)(lds + key[2 * e + 1] * PITCH + row * 2)) * rk[2 * e + 1];
                w[e] = pk2(lo, hi);
            }
            *(u32x4*)(VT + ((size_t)(b * NH + h) * VD + d) * SEQ + s0 + ch * 8) = (u32x4){w[0], w[1], w[2], w[3]};
        }
        __syncthreads();
    }
}

#define MFMA32(a, b, c) __builtin_amdgcn_mfma_f32_32x32x16_bf16((a), (b), (c), 0, 0, 0)
constexpr int KTILE = 64 * QKD * 2  , VTILE = VD * 64 * 2  , KRING = 0, VRING = 3 * KTILE;
#define ATT_DMA(gptr, ldsoff) __builtin_amdgcn_global_load_lds((const unsigned*)(gptr), (LAS unsigned*)(lds + (ldsoff)), 16, 0, 0)
#define ATT_ISSUE_K(jt, stage) do { _Pragma("unroll") for (int i_ = 0; i_ < 3; ++i_) ATT_DMA(kg + (size_t)(jt) * KTILE + kgo[i_], KRING + (stage) * KTILE + (wave * 3 + i_) * 1024); } while (0)
#define ATT_ISSUE_V(jt, stage) do { _Pragma("unroll") for (int i_ = 0; i_ < 2; ++i_) ATT_DMA(vg + (size_t)(jt) * 128 + vgo[i_], VRING + (stage) * VTILE + (wave * 2 + i_) * 1024); } while (0)

__device__ __forceinline__ void attn_unit(LAS unsigned char* lds, const bf16_t* Qg, const bf16_t* Kg, const bf16_t* Vtg, bf16_t* Og, int bh, int qb, int tid_, int wave, int lane_) {
    int tid = tid_; asm volatile("" : "+v"(tid));
    const int lane = tid & 63;
    const int rg = wave & 3, kh = wave >> 2, r = lane & 31, hi = lane >> 5;
    const int b = bh >> 2, h = bh & 3;
    const int nt = 2 * (qb + 1);
    const float NEG = -1e30f;
    bf16x8 qf[12];
    { const bf16_t* qp = Qg + ((size_t)bh * SEQ + 128 * qb + 32 * rg + r) * QKD + 8 * hi;
#pragma unroll
      for (int kk = 0; kk < 12; ++kk) qf[kk] = *(const bf16x8*)(qp + 16 * kk); }
    const unsigned char* kg = (const unsigned char*)(Kg + (size_t)bh * SEQ * QKD);
    const unsigned char* vg = (const unsigned char*)(Vtg + (size_t)bh * VD * SEQ);
    unsigned kgo[3], vgo[2];
#pragma unroll
    for (int i = 0; i < 3; ++i) { const int a = (wave * 3 + i) * 1024 + lane * 16, row = a / 384, cp = (a % 384) >> 4, cl = (cp & ~7) | ((cp ^ (row >> 1)) & 7); kgo[i] = (unsigned)(row * 384 + cl * 16); }
#pragma unroll
    for (int i = 0; i < 2; ++i) { const int a = (wave * 2 + i) * 1024 + lane * 16, row = a >> 7, cp = (a & 127) >> 4, cl = (cp ^ (row >> 1)) & 7; vgo[i] = (unsigned)(row * (SEQ * 2) + cl * 16); }
    const int sw = (r >> 1) & 7;
    unsigned kro[4], vro[2];
#pragma unroll
    for (int q = 0; q < 4; ++q) kro[q] = (unsigned)((32 * kh + r) * 384 + (((2 * q + hi) ^ sw) * 16));
#pragma unroll
    for (int s = 0; s < 2; ++s) vro[s] = (unsigned)(VRING + r * 128 + (((4 * kh + 2 * s + hi) ^ sw) * 16));
    f32x16 o[4]; float mrun = NEG, lrun = 0.f;
#pragma unroll
    for (int dt = 0; dt < 4; ++dt)
#pragma unroll
        for (int i = 0; i < 16; ++i) o[dt][i] = 0.f;
    ATT_ISSUE_K(0, 0); ATT_ISSUE_V(0, 0); ATT_ISSUE_K(1, 1);
    ATT_ISSUE_K((2 < nt) ? 2 : nt - 1, 2); ATT_ISSUE_V(1, 1);
    asm volatile("s_waitcnt vmcnt(5)" ::: "memory"); __builtin_amdgcn_s_barrier(); asm volatile("" ::: "memory");
    f32x16 sc, sn;
    {
#pragma unroll
      for (int i = 0; i < 16; ++i) sc[i] = 0.f;
#pragma unroll
      for (int kk = 0; kk < 12; ++kk) { const bf16x8 kf = *(const LAS bf16x8*)(lds + KRING + kro[kk & 3] + (kk >> 2) * 128); sc = MFMA32(kf, qf[kk], sc); if ((kk & 3) == 3) __builtin_amdgcn_sched_barrier(0); } }
    asm volatile("s_waitcnt lgkmcnt(0)" ::: "memory"); __builtin_amdgcn_s_barrier(); asm volatile("" ::: "memory");
    const float NINF = -__builtin_inff();
    int s0 = 0, s1 = 1, s2 = 2;
    for (int j = 0; j < nt; ++j) {
        const int relc = 64 * (j - 2 * qb) + 32 * kh - 32 * rg;
        const int j3 = (j + 3 < nt) ? j + 3 : nt - 1, j2 = (j + 2 < nt) ? j + 2 : nt - 1;
        const LAS unsigned char* kb = lds + KRING + s1 * KTILE;
        const LAS unsigned char* vb = lds + s0 * VTILE;
        if (relc >= 0) {
            const int thr = (relc == 0) ? r : -1;
#pragma unroll
            for (int i = 0; i < 16; ++i) { const int key = (i & 3) + 8 * (i >> 2) + 4 * hi; if (key > thr) sc[i] = NINF; }
        }
#define ATT_KRD(dst, g) do { _Pragma("unroll") for (int q_ = 0; q_ < 4; ++q_) dst[q_] = *(const LAS bf16x8*)(kb + kro[q_] + (g) * 128); } while (0)
        bf16x8 fa[4], fb[4];
        ATT_KRD(fa, 0); ATT_KRD(fb, 1);
#pragma unroll
        for (int i = 0; i < 16; ++i) sn[i] = 0.f;
        float mx = sc[0];
#pragma unroll
        for (int i = 1; i < 16; ++i) mx = fmaxf(mx, sc[i]);
        mx = max_xor32(mx);
#pragma unroll
        for (int q = 0; q < 4; ++q) sn = MFMA32(fa[q], qf[q], sn);
        ATT_KRD(fa, 2);
        __builtin_amdgcn_sched_barrier(0);
        if (__builtin_amdgcn_ballot_w64(mx > mrun + 8.f) != 0ull) {
            const float mnew = fmaxf(mrun, mx); const float alpha = __builtin_amdgcn_exp2f(mrun - mnew); mrun = mnew; lrun *= alpha;
#pragma unroll
            for (int dt = 0; dt < 4; ++dt) o[dt] = o[dt] * alpha;
        }
        float ps = 0.f; u32x4 p0, p1;
#pragma unroll
        for (int q = 0; q < 4; ++q) sn = MFMA32(fb[q], qf[4 + q], sn);
#pragma unroll
        for (int i = 0; i < 8; ++i) { sc[i] = __builtin_amdgcn_exp2f(sc[i] - mrun); ps += sc[i]; }
        p0.x = pk2(sc[0], sc[1]); p0.y = pk2(sc[2], sc[3]); p0.z = pk2(sc[4], sc[5]); p0.w = pk2(sc[6], sc[7]);
        __builtin_amdgcn_sched_barrier(0);
        ATT_ISSUE_K(j3, s0);
        __builtin_amdgcn_sched_barrier(0);
#pragma unroll
        for (int dt = 0; dt < 4; ++dt) fb[dt] = *(const LAS bf16x8*)(vb + vro[0] + dt * 4096);
#pragma unroll
        for (int q = 0; q < 4; ++q) sn = MFMA32(fa[q], qf[8 + q], sn);
#pragma unroll
        for (int i = 8; i < 12; ++i) { sc[i] = __builtin_amdgcn_exp2f(sc[i] - mrun); ps += sc[i]; }
        p1.x = pk2(sc[8], sc[9]); p1.y = pk2(sc[10], sc[11]);
        __builtin_amdgcn_sched_barrier(0);
        ATT_ISSUE_V(j2, s2);
        __builtin_amdgcn_sched_barrier(0);
#pragma unroll
        for (int dt = 0; dt < 4; ++dt) fa[dt] = *(const LAS bf16x8*)(vb + vro[1] + dt * 4096);
        { const bf16x8 pf0 = __builtin_bit_cast(bf16x8, p0);
          o[0] = MFMA32(fb[0], pf0, o[0]); o[1] = MFMA32(fb[1], pf0, o[1]); o[2] = MFMA32(fb[2], pf0, o[2]); o[3] = MFMA32(fb[3], pf0, o[3]); }
#pragma unroll
        for (int i = 12; i < 16; ++i) { sc[i] = __builtin_amdgcn_exp2f(sc[i] - mrun); ps += sc[i]; }
        p1.z = pk2(sc[12], sc[13]); p1.w = pk2(sc[14], sc[15]);
        lrun += ps;
        __builtin_amdgcn_sched_barrier(0);
        { const bf16x8 pf1 = __builtin_bit_cast(bf16x8, p1);
          o[0] = MFMA32(fa[0], pf1, o[0]); o[1] = MFMA32(fa[1], pf1, o[1]); o[2] = MFMA32(fa[2], pf1, o[2]); o[3] = MFMA32(fa[3], pf1, o[3]); }
        asm volatile("s_waitcnt vmcnt(5) lgkmcnt(0)" ::: "memory"); __builtin_amdgcn_s_barrier(); asm volatile("" ::: "memory");
        sc = sn;
        { const int t = s0; s0 = s1; s1 = s2; s2 = t; }
    }
    asm volatile("s_waitcnt vmcnt(0) lgkmcnt(0)" ::: "memory"); __builtin_amdgcn_s_barrier(); asm volatile("" ::: "memory");
    LAS float* cs = (LAS float*)(lds + rg * (66 * 64 * 4)) + lane;
    if (kh == 1) {
#pragma unroll
        for (int dt = 0; dt < 4; ++dt)
#pragma unroll
            for (int i = 0; i < 16; ++i) cs[(dt * 16 + i) * 64] = o[dt][i];
        cs[64 * 64] = mrun; cs[65 * 64] = lrun;
    }
    __syncthreads();
    if (kh == 0) {
        const float m1 = cs[64 * 64], l1 = cs[65 * 64];
        const float mf = fmaxf(mrun, m1), a0 = __builtin_amdgcn_exp2f(mrun - mf), a1 = __builtin_amdgcn_exp2f(m1 - mf);
        float lt = lrun * a0 + l1 * a1; lt += __shfl_xor(lt, 32);
        const float inv = 1.f / lt;
        bf16_t* op = Og + ((size_t)b * SEQ + 128 * qb + 32 * rg + r) * AW + h * VD + 4 * hi;
#pragma unroll
        for (int dt = 0; dt < 4; ++dt)
#pragma unroll
            for (int g = 0; g < 4; ++g) {
                float v[4];
#pragma unroll
                for (int e = 0; e < 4; ++e) v[e] = (o[dt][4 * g + e] * a0 + cs[(dt * 16 + 4 * g + e) * 64] * a1) * inv;
                u32x2 w; w.x = pk2(v[0], v[1]); w.y = pk2(v[2], v[3]);
                *(u32x2*)(op + 32 * dt + 8 * g) = w;
            }
    }
    __syncthreads();
}

__device__ __forceinline__ void unpack8(const u32x4 v, float (&f)[8]) { f[0] = bflo(v.x); f[1] = bfhi(v.x); f[2] = bflo(v.y); f[3] = bfhi(v.y); f[4] = bflo(v.z); f[5] = bfhi(v.z); f[6] = bflo(v.w); f[7] = bfhi(v.w); }
struct Tok6 { u32x4 o, za, g, pr; };
__device__ __forceinline__ void p6_load(Tok6& t, const bf16_t* PROJ, const bf16_t* O, int m, int c0) {
    const bf16_t* pr = PROJ + (size_t)m * PP;
    t.o = *(const u32x4*)(O + (size_t)m * AW + c0); t.za = *(const u32x4*)(pr + C_ZA + c0); t.g = *(const u32x4*)(pr + C_G + c0); t.pr = *(const u32x4*)(pr + C_PR + c0);
}
__device__ __forceinline__ void phase6(const Args& a, int gw, int NGW, int lane_) {
    int lane = lane_; asm volatile("" : "+v"(lane));
    const bf16_t* PROJ = (const bf16_t*)(a.ws + WS_PROJ); const bf16_t* O = (const bf16_t*)(a.ws + WS_QKVRAW); bf16_t* Y = (bf16_t*)(a.ws + WS_XN);
    const int c0 = 8 * lane;
    float goa[8], goc[8], w0[8], w1[8], w2[8];
#pragma unroll
    for (int e = 0; e < 8; ++e) { goa[e] = a.g_oa[c0 + e]; goc[e] = a.g_oc[c0 + e]; w0[e] = a.conv_w[c0 + e]; w1[e] = a.conv_w[CW + c0 + e]; w2[e] = a.conv_w[2 * CW + c0 + e]; }
    for (int ch = gw; ch < T / 8; ch += NGW) {
        const int m0 = ch * 8, s0 = m0 % SEQ;
        float pm2[8], pm1[8];
        if (s0 >= 2) { unpack8(*(const u32x4*)(PROJ + (size_t)(m0 - 1) * PP + C_PR + c0), pm1); unpack8(*(const u32x4*)(PROJ + (size_t)(m0 - 2) * PP + C_PR + c0), pm2); }
        else {
#pragma unroll
            for (int e = 0; e < 8; ++e) { pm1[e] = 0.f; pm2[e] = 0.f; }
        }
        Tok6 cur, nxt; p6_load(cur, PROJ, O, m0, c0);
#pragma unroll 1
        for (int i = 0; i < 8; ++i) {
            const int m = m0 + i;
            if (i < 7) p6_load(nxt, PROJ, O, m + 1, c0);
            float ov[8], za[8], gg[8], p0[8], v[8], u[8];
            unpack8(cur.o, ov); unpack8(cur.za, za); unpack8(cur.g, gg); unpack8(cur.pr, p0);
            float ss = 0.f, s2 = 0.f;
#pragma unroll
            for (int e = 0; e < 8; ++e) { v[e] = ov[e] * silu_f(za[e]); ss += v[e] * v[e];
                u[e] = gg[e] * (w2[e] * p0[e] + w1[e] * pm1[e] + w0[e] * pm2[e]); s2 += u[e] * u[e]; pm2[e] = pm1[e]; pm1[e] = p0[e]; }
#pragma unroll
            for (int o = 1; o < 64; o <<= 1) { ss += __shfl_xor(ss, o); s2 += __shfl_xor(s2, o); }
            const float rs = rsqrtf(ss * (1.f / AW) + EPS), rc = rsqrtf(s2 * (1.f / CW) + EPS);
            u32x4 w; w.x = pk2(v[0] * rs * goa[0], v[1] * rs * goa[1]); w.y = pk2(v[2] * rs * goa[2], v[3] * rs * goa[3]); w.z = pk2(v[4] * rs * goa[4], v[5] * rs * goa[5]); w.w = pk2(v[6] * rs * goa[6], v[7] * rs * goa[7]);
            *(u32x4*)(Y + (size_t)m * DM + c0) = w;
            w.x = pk2(u[0] * rc * goc[0], u[1] * rc * goc[1]); w.y = pk2(u[2] * rc * goc[2], u[3] * rc * goc[3]); w.z = pk2(u[4] * rc * goc[4], u[5] * rc * goc[5]); w.w = pk2(u[6] * rc * goc[6], u[7] * rc * goc[7]);
            *(u32x4*)(Y + (size_t)m * DM + AW + c0) = w;
            cur = nxt;
        }
    }
}

#define XB_TMO      128
#define XB_XCNT(j)  (256  + 64 * (j))
#define XB_XSUB(j)  (1280 + 64 * (j))
#define XB_XGEN(j)  (2304 + 64 * (j))
#define XB_TOP      3328
#define XB_TOPGEN   3392
#define XCD_BAR_WORDS 3456
#define XB_SPIN_CAP (1u << 18)

__device__ __forceinline__ unsigned xb_ld(unsigned* p)              { return __hip_atomic_load(p, __ATOMIC_RELAXED, __HIP_MEMORY_SCOPE_AGENT); }
__device__ __forceinline__ unsigned xb_add(unsigned* p, unsigned v) { return __hip_atomic_fetch_add(p, v, __ATOMIC_RELAXED, __HIP_MEMORY_SCOPE_AGENT); }
__device__ __forceinline__ unsigned xb_xcc_id() { return (unsigned)__builtin_amdgcn_s_getreg((3 << 11) | 20) & 0xFu; }
#define XB_SPIN(cond, bar) do { unsigned _sp = 0; while (cond) { __builtin_amdgcn_s_sleep(1); \
    if ((++_sp & 255u) == 0u) { if (xb_ld(&(bar)[XB_TMO])) break; if (_sp > XB_SPIN_CAP) { atomicAdd(&(bar)[XB_TMO], 1u); break; } } } } while (0)

struct XcdBarrier {
    unsigned* bar; unsigned x;
    volatile LAS unsigned* st;
};

__device__ __forceinline__ XcdBarrier xcd_barrier_post(unsigned* bar, volatile LAS unsigned* st) {
    XcdBarrier b; b.bar = bar; b.x = xb_xcc_id(); b.st = st;
    if (threadIdx.x == 0) (void)xb_add(&bar[XB_XCNT(b.x)], 1u);
    return b;
}
__device__ __forceinline__ void xcd_barrier_complete(unsigned* bar, unsigned x, unsigned& nloc, unsigned& nx) {
    const unsigned G = gridDim.x * gridDim.y * gridDim.z;
    unsigned sum, cnt, mine, sp = 0u;
    for (;;) {
        sum = 0u; cnt = 0u; mine = 0u;
#pragma unroll
        for (unsigned j = 0; j < 16; ++j) { const unsigned c = xb_ld(&bar[XB_XCNT(j)]); sum += c; cnt += (c > 0u) ? 1u : 0u; mine = (j == x) ? c : mine; }
        if (sum == G) break;
        __builtin_amdgcn_s_sleep(1);
        if ((++sp & 255u) == 0u) { if (xb_ld(&bar[XB_TMO])) break; if (sp > XB_SPIN_CAP) { atomicAdd(&bar[XB_TMO], 1u); break; } }
    }
    nloc = mine > 0u ? mine : 1u; nx = cnt > 0u ? cnt : 1u;
}

__device__ __forceinline__ void xcd_barrier(const XcdBarrier& b) {
    asm volatile("s_waitcnt vmcnt(0)" ::: "memory");
    __syncthreads();
    if (threadIdx.x == 0) {
        unsigned* bar = b.bar;
        __builtin_amdgcn_s_waitcnt(0);
        unsigned nloc = b.st[0], nx = b.st[1];
        if (nloc == 0u) { xcd_barrier_complete(bar, b.x, nloc, nx); b.st[0] = nloc; b.st[1] = nx; }
        const unsigned old = xb_add(&bar[XB_XSUB(b.x)], 1u);
        const unsigned gen = old / nloc;
        if (old + 1u == (gen + 1u) * nloc) {
            __builtin_amdgcn_fence(__ATOMIC_RELEASE, "agent");
            asm volatile("s_waitcnt vmcnt(0)" ::: "memory");
            const unsigned og = xb_add(&bar[XB_TOP], 1u);
            const unsigned tg = og / nx;
            if (og + 1u == (tg + 1u) * nx) xb_add(&bar[XB_TOPGEN], 1u);
            else XB_SPIN(xb_ld(&bar[XB_TOPGEN]) == tg, bar);
            __builtin_amdgcn_fence(__ATOMIC_ACQUIRE, "agent");
            xb_add(&bar[XB_XGEN(b.x)], 1u);
            asm volatile("s_waitcnt vmcnt(0)" ::: "memory");
        } else {
            XB_SPIN(xb_ld(&bar[XB_XGEN(b.x)]) == gen, bar);
            __builtin_amdgcn_fence(__ATOMIC_ACQUIRE, "agent");
            asm volatile("s_waitcnt vmcnt(0)" ::: "memory");
        }
    }
    __syncthreads();
}

#define XB_EXIT XCD_BAR_WORDS
__device__ unsigned g_barw[XCD_BAR_WORDS + 64];
constexpr int LDS_BYTES = 132096;

__global__ void __launch_bounds__(NTHREADS, 2) fwd_megakernel(Args a) {
    extern __shared__ __attribute__((aligned(16))) unsigned char lds_raw[];
    LAS unsigned char* lds = (LAS unsigned char*)lds_raw;
    cg::grid_group grid = cg::this_grid();
    const int tid = threadIdx.x, lane = tid & 63, wave = __builtin_amdgcn_readfirstlane(tid >> 6);
    const int G = gridDim.x, gw = blockIdx.x * NWAVES + wave, NGW = G * NWAVES;
    unsigned char* ws = a.ws;
    bf16_t* XN = (bf16_t*)(ws + WS_XN); bf16_t* PROJ = (bf16_t*)(ws + WS_PROJ); bf16_t* RAW = (bf16_t*)(ws + WS_QKVRAW);

    unsigned* barw = g_barw;
    if (tid < 2) ((volatile LAS unsigned*)(lds + 131072))[tid] = 0u;
    __syncthreads();
    const XcdBarrier bar = xcd_barrier_post(barw, (volatile LAS unsigned*)(lds + 131072));
    if (a.never) grid.sync();
    phase0(a, lds, gw, NGW, wave, lane);
    xcd_barrier(bar);
#define G1_PL() { pg8::Gemm g{(const bf16_t*)(ws + WS_PB), (const bf16_t*)(ws + WS_WPL), T, DM, PLE, PLE}; pg8::StaticOrder S; S.init(T, DM, G, (int)blockIdx.x); \
      pg8::EpiPl E{(bf16_t*)(ws + WS_PL), DM}; pg8::gemm_phase<pg8::EpiPl, pg8::StaticOrder, true, true>(lds, g, S, E); }
    if (blockIdx.x & 1) G1_PL();
    { pg8::Gemm g{XN, (const bf16_t*)(ws + WS_WIN), T, 1024, DM, DM}; pg8::StaticOrder S; S.init(T, 1024, G, (int)blockIdx.x);
      pg8::EpiBf16<0> E{PROJ, PP};
      pg8::gemm_phase<pg8::EpiBf16<0>, pg8::StaticOrder, true, true>(lds, g, S, E); }
    { pg8::Gemm g{XN, (const bf16_t*)(ws + WS_WIN) + (size_t)1024 * DM, T, 2048, DM, DM}; pg8::StaticOrder S; S.init(T, 2048, G, (int)blockIdx.x);
      pg8::EpiProjB E{PROJ, PP};
      pg8::gemm_phase<pg8::EpiProjB, pg8::StaticOrder, true, true>(lds, g, S, E); }
    if (!(blockIdx.x & 1)) G1_PL();
    xcd_barrier(bar);
    { pg8::Gemm g{PROJ, (const bf16_t*)(ws + WS_WUP), T, UPN, UPK, PP}; pg8::StaticOrder S; S.init(T, UPN, G, (int)blockIdx.x);
      pg8::EpiBf16<0> E{RAW, UPN};
      pg8::gemm_phase<pg8::EpiBf16<0>, pg8::StaticOrder, true, true>(lds, g, S, E); }
    { const int nunits = (T / 256) * (UPN / 256), idle0 = (nunits - G > 0 && nunits - G < G) ? nunits - G : 0;
      if ((int)blockIdx.x >= idle0) late_transposes(a, lds, ((int)blockIdx.x - idle0) * NWAVES + wave, (G - idle0) * NWAVES, wave, lane); }
    xcd_barrier(bar);
    phase4a(a, gw, NGW, lane);
    phase4b(a, lds, tid);
    xcd_barrier(bar);
    { const bf16_t* Qg = XN; const bf16_t* Kg = (const bf16_t*)(ws + WS_K); const bf16_t* Vtg = (const bf16_t*)(ws + WS_VT); bf16_t* Og = RAW;
      for (int c = blockIdx.x; c < 256; c += G) { const int bh = c & 7, pi = c >> 3;
          attn_unit(lds, Qg, Kg, Vtg, Og, bh, 63 - pi, tid, wave, lane);
          attn_unit(lds, Qg, Kg, Vtg, Og, bh, pi, tid, wave, lane); } }
    xcd_barrier(bar);
    phase6(a, gw, NGW, lane);
    xcd_barrier(bar);
    { pg8::Gemm g{XN, (const bf16_t*)(ws + WS_WO), T, DM, DM, DM}; pg8::StaticOrder S; S.init(T, DM, G, (int)blockIdx.x);
      pg8::EpiX1 E{a.x, a.out, (bf16_t*)(ws + WS_X1B), (float*)(ws + WS_ROWSQ), DM};
      pg8::gemm_phase<pg8::EpiX1, pg8::StaticOrder, true, true>(lds, g, S, E); }
    xcd_barrier(bar);
    { pg8::Gemm g{(const bf16_t*)(ws + WS_X1B), (const bf16_t*)(ws + WS_WPLG), T, DM, DM, DM}; pg8::StaticOrder S; S.init(T, DM, G, (int)blockIdx.x);
      pg8::EpiGateOut E{(const bf16_t*)(ws + WS_PL), (const bf16_t*)(ws + WS_X1B), a.out, (const float*)(ws + WS_ROWSQ), DM, EPS};
      pg8::gemm_phase<pg8::EpiGateOut, pg8::StaticOrder, true, true>(lds, g, S, E); }
    __syncthreads();
    { LAS unsigned* flag = (LAS unsigned*)(lds + 131072 + 16);
      if (tid == 0) flag[0] = (xb_add(&barw[XB_EXIT], 1u) == (unsigned)G - 1u) ? 1u : 0u;
      __syncthreads();
      if (flag[0]) { for (int i = tid; i < XCD_BAR_WORDS + 64; i += NTHREADS) __hip_atomic_store(&barw[i], 0u, __ATOMIC_RELAXED, __HIP_MEMORY_SCOPE_AGENT); } }
}

extern "C" void kernel_launch(void* const* d_in, const int* in_sizes, int n_in, void* d_out, int out_size, void* d_ws, size_t ws_size, hipStream_t stream) {
    static int grid = 0;
    if (grid == 0) {
        if (n_in != 18 || in_sizes[0] != T * DM || out_size != T * DM || ws_size < WS_END) { fprintf(stderr, "kernel_launch: unexpected shapes (n_in %d, in0 %d, out %d, ws %zu)\n", n_in, n_in > 0 ? in_sizes[0] : -1, out_size, ws_size); grid = -1; return; }
        int dev = 0, cus = 0, per_cu = 0;
        hipGetDevice(&dev); hipDeviceGetAttribute(&cus, hipDeviceAttributeMultiprocessorCount, dev);
        if (hipFuncSetAttribute((const void*)fwd_megakernel, hipFuncAttributeMaxDynamicSharedMemorySize, LDS_BYTES) != hipSuccess) { fprintf(stderr, "kernel_launch: hipFuncSetAttribute failed\n"); }
        if (hipOccupancyMaxActiveBlocksPerMultiprocessor(&per_cu, (const void*)fwd_megakernel, NTHREADS, LDS_BYTES) != hipSuccess || per_cu < 1) { fprintf(stderr, "kernel_launch: occupancy query says %d\n", per_cu); per_cu = 1; }
        (void)hipGetLastError();
        grid = cus * (per_cu > 1 ? 1 : per_cu);
        if (grid <= 0) grid = 256;
    }
    if (grid < 0) return;
    Args a{};
    a.x = (const float*)d_in[0]; a.p = (const float*)d_in[1]; a.pos = (const int*)d_in[2]; a.g_in = (const float*)d_in[3]; a.w_in = (const float*)d_in[4];
    a.g_cq = (const float*)d_in[5]; a.w_uq = (const float*)d_in[6]; a.g_ckv = (const float*)d_in[7]; a.w_ukv = (const float*)d_in[8];
    a.g_q = (const float*)d_in[9]; a.g_k = (const float*)d_in[10]; a.conv_w = (const float*)d_in[11]; a.g_oa = (const float*)d_in[12]; a.g_oc = (const float*)d_in[13];
    a.w_o = (const float*)d_in[14]; a.w_pl = (const float*)d_in[15]; a.w_plg = (const float*)d_in[16]; a.g_pl = (const float*)d_in[17];
    a.out = (float*)d_out; a.ws = (unsigned char*)d_ws;
    void* args[] = {&a};
    hipError_t e = hipLaunchCooperativeKernel((const void*)fwd_megakernel, dim3(grid), dim3(NTHREADS), args, LDS_BYTES, stream);
    if (e != hipSuccess) fprintf(stderr, "cooperative launch failed: %s (grid %d)\n", hipGetErrorString(e), grid);
}
```
